# Optimizing an MI355X kernel written in HIP

```python
import jax, jax.numpy as jnp
from jax import lax
import numpy as np

D_MODEL = 1024
BATCH = 4
SEQ = 8192
DEPTH = 2

N_MIXERS = 2
D_FF = 4 * D_MODEL
EPS = 1e-6

GLA_HEADS = 4
GLA_DK = D_MODEL // 2
GLA_DV = D_MODEL
GLA_HEAD_K = GLA_DK // GLA_HEADS
GLA_HEAD_V = GLA_DV // GLA_HEADS
GLA_GATE_RANK = 16
GLA_GATE_NORM = 16.0
GLA_CHUNK = 64
GLA_IN = 2 * GLA_DK + 2 * GLA_DV + GLA_GATE_RANK

FOX_HEADS = 16
FOX_HEAD_DIM = D_MODEL // FOX_HEADS
FOX_BLOCK = 128
FOX_IN = 3 * D_MODEL + FOX_HEADS + D_MODEL

kernel_name = "gla_fox_interleaved_hybrid"


def rms_norm(x, g):
    xf = x.astype(jnp.float32)
    y = xf * lax.rsqrt(jnp.mean(xf * xf, axis=-1, keepdims=True) + EPS)
    return (y * g.astype(jnp.float32)).astype(x.dtype)


def sqrelu_mlp(h, w1, w2):
    return jnp.square(jax.nn.relu(h @ w1)) @ w2


def gla_mixer(h, w_in, w_gk_up, b_gk, g_onorm, w_out):
    B, S, _ = h.shape
    C = GLA_CHUNK
    N = S // C
    proj = h @ w_in
    q, k, v, r, gk_low = jnp.split(
        proj, [GLA_DK, 2 * GLA_DK, 2 * GLA_DK + GLA_DV, 2 * GLA_DK + 2 * GLA_DV], axis=-1)
    log_a = jax.nn.log_sigmoid((gk_low @ w_gk_up + b_gk).astype(jnp.float32)) / GLA_GATE_NORM

    def to_chunks(t, dh):
        return t.astype(jnp.float32).reshape(B, N, C, GLA_HEADS, dh).transpose(1, 0, 3, 2, 4)

    qc = to_chunks(q, GLA_HEAD_K) * (GLA_HEAD_K ** -0.5)
    kc = to_chunks(k, GLA_HEAD_K)
    vc = to_chunks(v, GLA_HEAD_V)
    gc = to_chunks(log_a, GLA_HEAD_K)
    causal = jnp.tril(jnp.ones((C, C), dtype=bool))

    def step(state, inp):
        qb, kb, vb, gb = inp
        b = jnp.cumsum(gb, axis=-2)
        o_inter = jnp.einsum('bhck,bhkv->bhcv', qb * jnp.exp(b), state)
        diff = b[:, :, :, None, :] - b[:, :, None, :, :]
        decay = jnp.exp(jnp.where(causal[:, :, None], diff, -jnp.inf))
        attn = jnp.einsum('bhik,bhjk,bhijk->bhij', qb, kb, decay)
        o_intra = jnp.einsum('bhij,bhjv->bhiv', attn, vb)
        b_last = b[:, :, -1:, :]
        k_dec = kb * jnp.exp(b_last - b)
        state = state * jnp.exp(b_last[:, :, 0, :])[..., None] + jnp.einsum('bhck,bhcv->bhkv', k_dec, vb)
        return state, o_inter + o_intra

    state0 = jnp.zeros((B, GLA_HEADS, GLA_HEAD_K, GLA_HEAD_V), jnp.float32)
    _, o = lax.scan(step, state0, (qc, kc, vc, gc))
    o = o.transpose(1, 0, 3, 2, 4).reshape(B, S, GLA_HEADS, GLA_HEAD_V).astype(h.dtype)
    o = rms_norm(o, g_onorm).reshape(B, S, GLA_DV)
    return (o * jax.nn.silu(r)) @ w_out


def fox_mixer(h, w_in, b_f, g_q, g_k, w_out):
    B, S, _ = h.shape
    H, Dh = FOX_HEADS, FOX_HEAD_DIM
    nb = S // FOX_BLOCK
    proj = h @ w_in
    q, k, v, f_logit, o_gate = jnp.split(
        proj, [D_MODEL, 2 * D_MODEL, 3 * D_MODEL, 3 * D_MODEL + H], axis=-1)
    q = rms_norm(q.reshape(B, S, H, Dh), g_q).transpose(0, 2, 1, 3)
    k = rms_norm(k.reshape(B, S, H, Dh), g_k).transpose(0, 2, 1, 3)
    v = v.reshape(B, S, H, Dh).transpose(0, 2, 1, 3)
    log_f = jax.nn.log_sigmoid((f_logit + b_f).astype(jnp.float32))
    c = jnp.cumsum(log_f, axis=1).transpose(0, 2, 1)
    scale = Dh ** -0.5
    key_pos = jnp.arange(S)
    q_blocks = q.reshape(B, H, nb, FOX_BLOCK, Dh).transpose(2, 0, 1, 3, 4)
    c_blocks = c.reshape(B, H, nb, FOX_BLOCK).transpose(2, 0, 1, 3)

    def attend(args):
        qb, cq, blk = args
        s = jnp.einsum('bhqd,bhkd->bhqk', qb, k).astype(jnp.float32) * scale
        s = s + cq[..., None] - c[:, :, None, :]
        q_pos = blk * FOX_BLOCK + jnp.arange(FOX_BLOCK)
        s = jnp.where(key_pos[None, :] <= q_pos[:, None], s, -jnp.inf)
        p = jax.nn.softmax(s, axis=-1)
        return jnp.einsum('bhqk,bhkd->bhqd', p.astype(v.dtype), v)

    o = lax.map(attend, (q_blocks, c_blocks, jnp.arange(nb)))
    o = o.transpose(1, 0, 3, 2, 4).reshape(B, S, D_MODEL)
    return (o * jax.nn.sigmoid(o_gate)) @ w_out


def setup_inputs(seed: int = 0) -> dict:
    key = jax.random.key(seed)
    ks = jax.random.split(key, 24)
    f32 = jnp.float32
    nrm = lambda k, shape, fan_in: jax.random.normal(k, shape, f32) * (fan_in ** -0.5)
    gain = lambda k, n: 1.0 + 0.05 * jax.random.normal(k, (n,), f32)
    return {
        "x": jax.random.normal(ks[0], (BATCH, SEQ, D_MODEL), f32),
        "l0_norm_mix": gain(ks[1], D_MODEL),
        "l0_w_in": nrm(ks[2], (D_MODEL, GLA_IN), D_MODEL),
        "l0_w_gk_up": nrm(ks[3], (GLA_GATE_RANK, GLA_DK), GLA_GATE_RANK),
        "l0_b_gk": 0.1 * jax.random.normal(ks[4], (GLA_DK,), f32),
        "l0_g_onorm": gain(ks[5], GLA_HEAD_V),
        "l0_w_out": nrm(ks[6], (GLA_DV, D_MODEL), GLA_DV),
        "l0_norm_ffn": gain(ks[7], D_MODEL),
        "l0_w_ff1": nrm(ks[8], (D_MODEL, D_FF), D_MODEL),
        "l0_w_ff2": nrm(ks[9], (D_FF, D_MODEL), D_FF),
        "l1_norm_mix": gain(ks[10], D_MODEL),
        "l1_w_in": nrm(ks[11], (D_MODEL, FOX_IN), D_MODEL),
        "l1_b_f": jax.random.uniform(ks[12], (FOX_HEADS,), f32, 1.0, 5.0),
        "l1_g_q": gain(ks[13], FOX_HEAD_DIM),
        "l1_g_k": gain(ks[14], FOX_HEAD_DIM),
        "l1_w_out": nrm(ks[15], (D_MODEL, D_MODEL), D_MODEL),
        "l1_norm_ffn": gain(ks[16], D_MODEL),
        "l1_w_ff1": nrm(ks[17], (D_MODEL, D_FF), D_MODEL),
        "l1_w_ff2": nrm(ks[18], (D_FF, D_MODEL), D_FF),
        "final_norm": gain(ks[19], D_MODEL),
    }


def reference(x, l0_norm_mix, l0_w_in, l0_w_gk_up, l0_b_gk, l0_g_onorm, l0_w_out,
              l0_norm_ffn, l0_w_ff1, l0_w_ff2,
              l1_norm_mix, l1_w_in, l1_b_f, l1_g_q, l1_g_k, l1_w_out,
              l1_norm_ffn, l1_w_ff1, l1_w_ff2, final_norm):
    layers = (
        (l0_norm_mix, (l0_w_in, l0_w_gk_up, l0_b_gk, l0_g_onorm, l0_w_out), l0_norm_ffn, l0_w_ff1, l0_w_ff2),
        (l1_norm_mix, (l1_w_in, l1_b_f, l1_g_q, l1_g_k, l1_w_out), l1_norm_ffn, l1_w_ff1, l1_w_ff2),
    )
    mixers = (gla_mixer, fox_mixer)
    for i in range(DEPTH):
        norm_mix, mix_params, norm_ffn, w1, w2 = layers[i]
        x = x + mixers[i % N_MIXERS](rms_norm(x, norm_mix), *mix_params)
        x = x + sqrelu_mlp(rms_norm(x, norm_ffn), w1, w2)
    return rms_norm(x, final_norm)
```

```cpp
#include <hip/hip_runtime.h>
#include <hip/hip_cooperative_groups.h>
#include <hip/hip_bf16.h>
#include <cstdio>
#include <cstdint>
#include <cmath>
namespace cg = cooperative_groups;
__device__ __forceinline__ int mk_tid() {
    const unsigned hw = __builtin_amdgcn_s_getreg(4 | ((6 - 1) << 11)) & 63u;
    const int wave = *(const volatile __attribute__((address_space(3))) int*)(unsigned)(131072u + 4u * hw);
    int lane; asm volatile("v_mbcnt_lo_u32_b32 %0, -1, 0\n\tv_mbcnt_hi_u32_b32 %0, -1, %0" : "=v"(lane));
    return __builtin_amdgcn_readfirstlane(wave) * 64 + lane;
}
namespace pg8 {
#define PG8_LAS __attribute__((address_space(3)))
typedef unsigned short bf16_t;
typedef short bf16x8 __attribute__((ext_vector_type(8)));
typedef float f32x4 __attribute__((ext_vector_type(4)));
typedef unsigned u32x4 __attribute__((ext_vector_type(4)));
constexpr int BM = 256, BK = 64, HALF = 128, HTB = HALF * BK * 2  , STAGE_BYTES = 8 * HTB, NXCD = 8, WGM = 8;

__host__ __device__ __forceinline__ int lds_byte(int r, int c) { const int st = (r >> 4) * 2 + (c >> 5), rr = r & 15, cc = c & 31, ob = rr * 64 + cc * 2; return st * 1024 + (ob ^ (((ob >> 9) & 1) << 5)); }
__host__ __device__ __forceinline__ void stage_rc(int b, int& R, int& C) { const int st = b / 1024, sb = b % 1024, swz = sb ^ (((sb >> 9) & 1) << 5); R = (st >> 1) * 16 + swz / 64; C = (st & 1) * 32 + (swz % 64) / 2; }
__host__ __device__ __forceinline__ int perm32(int rho) { const int n = rho >> 4, i = rho & 15; return 8 * (i >> 2) + 4 * n + (i & 3); }

struct Unit { int pm, pn; };
struct Gemm { const bf16_t* A; const bf16_t* Bt; int M, N, K; };

struct StaticOrder {
    int nM, nN, nwg, G, c;
    __host__ __device__ void init(int M, int N, int G_, int c_) { nM = M / BM; nN = N / BM; nwg = nM * nN; G = G_; c = c_; }
    __host__ __device__ bool next(int i, Unit& u) const {
        const long L = (long)i * G + c; if (L >= nwg) return false;
        int wgid = (int)L; { const int q = nwg / NXCD, r = nwg % NXCD, xcd = wgid % NXCD, off = wgid / NXCD; wgid = (xcd < r ? xcd * (q + 1) : r * (q + 1) + (xcd - r) * q) + off; }
        const int nig = WGM * nN, gid = wgid / nig, fm = gid * WGM, gsz = (nM - fm) < WGM ? (nM - fm) : WGM;
        u.pm = fm + ((wgid % nig) % gsz); u.pn = (wgid % nig) / gsz; return true;
    }
    __device__ __forceinline__ void a_ready(const Unit&) const {}
    __device__ __forceinline__ void done(const Unit&) const {}
};

__device__ __forceinline__ unsigned cvt_pk_bf16(float lo, float hi) { unsigned r; asm volatile("v_cvt_pk_bf16_f32 %0, %1, %2" : "=v"(r) : "v"(lo), "v"(hi)); return r; }
constexpr float EPS_ = 1e-6f;
template <int ACT  , int RSMODE  > struct EpiScaleBf16 {
    static constexpr bool PERM = true, AFTER_DRAIN = false;
    bf16_t* O; int ldc; const float* rs;
    __device__ __forceinline__ void pre(const Unit& u, int wr, int fr, float (&p)[8]) const { const int row0 = u.pm * BM + wr * 64 + fr;
#pragma unroll
        for (int i = 0; i < 8; ++i) p[i] = rs[row0 + (i >> 2) * HALF + (i & 3) * 16]; }
    __device__ __forceinline__ void operator()(const f32x4 (&acc)[2][2][4][2], const Unit& u, int wr, int wc, int fr, int fq, const float (&p)[8]) const {
        const int row0 = u.pm * BM + wr * 64 + fr, col0 = u.pn * BM + wc * 64 + 8 * fq;
        float sv[2][4];
#pragma unroll
        for (int i = 0; i < 8; ++i) sv[i >> 2][i & 3] = p[i];
#pragma unroll
        for (int ai = 0; ai < 2; ++ai)
#pragma unroll
            for (int m = 0; m < 4; ++m) { const int row = row0 + ai * HALF + m * 16; float s = sv[ai][m]; if (RSMODE == 1) s = __builtin_amdgcn_rsqf(s * (1.0f / 1024.0f) + EPS_);
                bf16_t* rowp = O + (size_t)row * ldc + col0;
#pragma unroll
                for (int bj = 0; bj < 2; ++bj) { f32x4 v0 = acc[ai][bj][m][0] * s, v1 = acc[ai][bj][m][1] * s;
                    if (ACT == 1) {
#pragma unroll
                        for (int i = 0; i < 4; ++i) { const float a = fmaxf(v0[i], 0.f), b = fmaxf(v1[i], 0.f); v0[i] = a * a; v1[i] = b * b; } }
                    u32x4 w; w.x = cvt_pk_bf16(v0[0], v0[1]); w.y = cvt_pk_bf16(v0[2], v0[3]); w.z = cvt_pk_bf16(v1[0], v1[1]); w.w = cvt_pk_bf16(v1[2], v1[3]);
                    *(u32x4*)(rowp + bj * 32) = w; } }
    }
};
template <bool BASE_BF16, bool OUT_F32, bool OUT_BF16> struct EpiRes {
    static constexpr bool PERM = false, AFTER_DRAIN = false;
    const float* base32; const bf16_t* base16; float* out; bf16_t* ob; float* ssq;
    __device__ __forceinline__ void pre(const Unit&, int, int, float (&p)[8]) const {
#pragma unroll
        for (int i = 0; i < 8; ++i) p[i] = 0.f; }
    __device__ __forceinline__ void operator()(const f32x4 (&acc)[2][2][4][2], const Unit& u, int wr, int wc, int fr, int fq, const float (&)[8]) const {
        typedef unsigned u32x2v __attribute__((ext_vector_type(2)));
        const int row0 = u.pm * BM + wr * 64 + fr, col0 = u.pn * BM + wc * 64 + 4 * fq;
#pragma unroll
        for (int ai = 0; ai < 2; ++ai) {
            f32x4 bv[4][2][2];
#pragma unroll
            for (int m = 0; m < 4; ++m)
#pragma unroll
                for (int bj = 0; bj < 2; ++bj)
#pragma unroll
                    for (int n = 0; n < 2; ++n) { const size_t o = (size_t)(row0 + ai * HALF + m * 16) * 1024 + col0 + bj * 32 + n * 16;
                        if (BASE_BF16) { const u32x2v w = *(const u32x2v*)(base16 + o); bv[m][bj][n] = (f32x4){__uint_as_float(w.x << 16), __uint_as_float(w.x & 0xffff0000u), __uint_as_float(w.y << 16), __uint_as_float(w.y & 0xffff0000u)}; }
                        else bv[m][bj][n] = *(const f32x4*)(base32 + o); }
#pragma unroll
            for (int m = 0; m < 4; ++m) { const int row = row0 + ai * HALF + m * 16; const size_t off = (size_t)row * 1024 + col0; float s = 0.f;
#pragma unroll
                for (int bj = 0; bj < 2; ++bj)
#pragma unroll
                    for (int n = 0; n < 2; ++n) { const size_t o = off + bj * 32 + n * 16; const f32x4 v = acc[ai][bj][m][n] + bv[m][bj][n];
                        if (OUT_F32) *(f32x4*)(out + o) = v;
                        s += (v[0] * v[0] + v[1] * v[1]) + (v[2] * v[2] + v[3] * v[3]);
                        if (OUT_BF16) { u32x2v w; w.x = cvt_pk_bf16(v[0], v[1]); w.y = cvt_pk_bf16(v[2], v[3]); *(u32x2v*)(ob + o) = w; } }
                s += __shfl_xor(s, 16); s += __shfl_xor(s, 32);
                if (fq == 0) atomicAdd(ssq + row, s); }
            asm volatile("" ::: "memory"); }
    }
};
struct EpiFox {
    static constexpr bool PERM = true, AFTER_DRAIN = false;
    bf16_t* Q; bf16_t* K; bf16_t* V; bf16_t* G; float* LF; const float* ssq; const float* gq; const float* gk; const float* bfg; float qscale; unsigned* nrm;
    __device__ __forceinline__ void pre(const Unit& u, int wr, int fr, float (&p)[8]) const { const int row0 = u.pm * BM + wr * 64 + fr;
#pragma unroll
        for (int i = 0; i < 8; ++i) p[i] = ssq[row0 + (i >> 2) * HALF + (i & 3) * 16]; }
    __device__ __forceinline__ void operator()(const f32x4 (&acc)[2][2][4][2], const Unit& u, int wr, int wc, int fr, int fq, const float (&p)[8]) const {
        const int kind = u.pn >> 2; const int row0 = u.pm * BM + wr * 64 + fr, col0 = (u.pn & 3) * BM + wc * 64 + 8 * fq;
        f32x4 gv[2][2]; const float* gsel = kind == 0 ? gq : gk; const float gsc = kind == 0 ? qscale : 1.0f;
#pragma unroll
        for (int bj = 0; bj < 2; ++bj)
#pragma unroll
            for (int n = 0; n < 2; ++n) gv[bj][n] = *(const f32x4*)(gsel + bj * 32 + 8 * fq + 4 * n) * gsc;
        bf16_t* dst = kind == 0 ? Q : kind == 1 ? K : kind == 2 ? V : G;
        float sq[2][4]; float nmax = 0.f;
#pragma unroll
        for (int i = 0; i < 8; ++i) sq[i >> 2][i & 3] = p[i];
#pragma unroll
        for (int ai = 0; ai < 2; ++ai)
#pragma unroll
            for (int m = 0; m < 4; ++m) { const int row = row0 + ai * HALF + m * 16; const float rs = __builtin_amdgcn_rsqf(sq[ai][m] * (1.0f / 1024.0f) + EPS_);
                f32x4 v[2][2];
#pragma unroll
                for (int bj = 0; bj < 2; ++bj)
#pragma unroll
                    for (int n = 0; n < 2; ++n) v[bj][n] = acc[ai][bj][m][n] * rs;
                if (kind < 2) { float s = 0.f;
#pragma unroll
                    for (int bj = 0; bj < 2; ++bj)
#pragma unroll
                        for (int n = 0; n < 2; ++n) s += (v[bj][n][0] * v[bj][n][0] + v[bj][n][1] * v[bj][n][1]) + (v[bj][n][2] * v[bj][n][2] + v[bj][n][3] * v[bj][n][3]);
                    s += __shfl_xor(s, 16); s += __shfl_xor(s, 32);
                    const float hn = __builtin_amdgcn_rsqf(s * (1.0f / 64.0f) + EPS_);
#pragma unroll
                    for (int bj = 0; bj < 2; ++bj)
#pragma unroll
                        for (int n = 0; n < 2; ++n) v[bj][n] = v[bj][n] * hn * gv[bj][n];
                    float n2 = 0.f;
#pragma unroll
                    for (int bj = 0; bj < 2; ++bj)
#pragma unroll
                        for (int n = 0; n < 2; ++n) n2 += (v[bj][n][0] * v[bj][n][0] + v[bj][n][1] * v[bj][n][1]) + (v[bj][n][2] * v[bj][n][2] + v[bj][n][3] * v[bj][n][3]);
                    n2 += __shfl_xor(n2, 16); n2 += __shfl_xor(n2, 32);
                    nmax = fmaxf(nmax, n2); }
                if (kind == 3) {
#pragma unroll
                    for (int bj = 0; bj < 2; ++bj)
#pragma unroll
                        for (int n = 0; n < 2; ++n)
#pragma unroll
                            for (int i = 0; i < 4; ++i) v[bj][n][i] = __builtin_amdgcn_rcpf(1.0f + __expf(-v[bj][n][i])); }
                {
                    bf16_t* rowp = dst + (size_t)row * 1024 + col0;
#pragma unroll
                    for (int bj = 0; bj < 2; ++bj) { u32x4 w; w.x = cvt_pk_bf16(v[bj][0][0], v[bj][0][1]); w.y = cvt_pk_bf16(v[bj][0][2], v[bj][0][3]); w.z = cvt_pk_bf16(v[bj][1][0], v[bj][1][1]); w.w = cvt_pk_bf16(v[bj][1][2], v[bj][1][3]);
                        *(u32x4*)(rowp + bj * 32) = w; } }
            }
        if (kind < 2) {
            nmax = fmaxf(nmax, __shfl_xor(nmax, 1)); nmax = fmaxf(nmax, __shfl_xor(nmax, 2)); nmax = fmaxf(nmax, __shfl_xor(nmax, 4)); nmax = fmaxf(nmax, __shfl_xor(nmax, 8));
            if (fr == 0 && fq == 0) atomicMax(nrm + kind * 64 + (u.pm >> 5) * 16 + (u.pn & 3) * 4 + wc, __float_as_uint(nmax)); }
    }
};


template <class Epi, class Sched, bool ALIGN_EPI = false, bool SP2 = false>
__device__ __forceinline__ void gemm_phase(PG8_LAS unsigned char* lds, const Gemm g, const Sched& S, const Epi& E) {
    const int tid = mk_tid(), wid = __builtin_amdgcn_readfirstlane(tid >> 6), lane = tid & 63, wr = wid >> 2, wc = wid & 3, fr = lane & 15, fq = lane >> 4;
    const int K = g.K, nt = K / BK;
    unsigned voffA[2], voffB[2];
#pragma unroll
    for (int i = 0; i < 2; ++i) { int R, C; stage_rc(tid * 16 + i * 8192, R, C); const int Rb = Epi::PERM ? ((R & ~31) + perm32(R & 31)) : R;
        voffA[i] = (unsigned)(R * K + C) * 2u; voffB[i] = (unsigned)(Rb * K + C) * 2u; }
    const size_t kstep = (size_t)(BK * 2);
    const size_t hstep = (size_t)HALF * K * 2;
    const size_t tstep = 2 * hstep;
    const unsigned ldsw = (unsigned)wid * 1024u;
    const int aoff = lds_byte(wr * 64 + fr, fq * 8), boff = lds_byte(wc * 32 + fr, fq * 8);
#define PG8_SA(b, h) (((b) * 2 + (h)) * HTB)
#define PG8_SB(b, h) ((4 + (b) * 2 + (h)) * HTB)
#define PG8_STAGE(bufoff, gbase, voff) do { _Pragma("unroll") for (int _i = 0; _i < 2; ++_i) \
        __builtin_amdgcn_global_load_lds((const unsigned*)((const char*)(gbase) + (voff)[_i]), (PG8_LAS unsigned*)(lds + (bufoff) + ldsw + _i * 8192), 16, 0, 0); } while (0)
#define PG8_LDA(dst, b, h) do { _Pragma("unroll") for (int m = 0; m < 4; ++m) _Pragma("unroll") for (int k = 0; k < 2; ++k) dst[m][k] = *(const PG8_LAS bf16x8*)(lds + PG8_SA(b, h) + aoff + m * 2048 + k * 1024); } while (0)
#define PG8_LDB(dst, b, h) do { _Pragma("unroll") for (int n = 0; n < 2; ++n) _Pragma("unroll") for (int k = 0; k < 2; ++k) dst[n][k] = *(const PG8_LAS bf16x8*)(lds + PG8_SB(b, h) + boff + n * 2048 + k * 1024); } while (0)
#define PG8_MMA(ai, bj, At, Bt) do { __builtin_amdgcn_s_setprio(1); _Pragma("unroll") for (int m = 0; m < 4; ++m) _Pragma("unroll") for (int n = 0; n < 2; ++n) _Pragma("unroll") for (int k = 0; k < 2; ++k) \
        acc[ai][bj][m][n] = __builtin_amdgcn_mfma_f32_16x16x32_bf16(Bt[n][k], At[m][k], acc[ai][bj][m][n], 0, 0, 0); __builtin_amdgcn_s_setprio(0); } while (0)
#define PG8_WAIT_V(n) asm volatile("s_waitcnt vmcnt(" #n ")" ::: "memory")
#define PG8_WAIT_L(n) asm volatile("s_waitcnt lgkmcnt(" #n ")" ::: "memory")
#define PG8_BAR __builtin_amdgcn_s_barrier()
#define PG8_SCHED __builtin_amdgcn_sched_barrier(0)
    Unit cur, nxt; int ui = 0;
    if (!S.next(0, cur)) return;
    float prew[8]; E.pre(cur, wr, fr, prew);
    f32x4 acc[2][2][4][2];
#pragma unroll
    for (int a = 0; a < 2; ++a)
#pragma unroll
        for (int b = 0; b < 2; ++b)
#pragma unroll
            for (int m = 0; m < 4; ++m)
#pragma unroll
                for (int n = 0; n < 2; ++n) acc[a][b][m][n] = (f32x4){0.f, 0.f, 0.f, 0.f};
    bf16x8 At[4][2], B0[2][2], B1[2][2];
    const char* cA = (const char*)g.A + (size_t)cur.pm * tstep; const char* cB = (const char*)g.Bt + (size_t)cur.pn * tstep;
    S.a_ready(cur);
    if constexpr (SP2) {
        PG8_STAGE(PG8_SB(0, 0), cB, voffB); PG8_STAGE(PG8_SB(0, 1), cB + hstep, voffB); PG8_STAGE(PG8_SA(0, 0), cA, voffA); PG8_STAGE(PG8_SA(0, 1), cA + hstep, voffA);
        if (wr == 1) PG8_BAR;
        PG8_WAIT_V(2); PG8_BAR;
        PG8_STAGE(PG8_SB(1, 0), cB + kstep, voffB); PG8_STAGE(PG8_SA(1, 0), cA + kstep, voffA); PG8_STAGE(PG8_SB(1, 1), cB + hstep + kstep, voffB);
        PG8_WAIT_V(6); PG8_BAR;
    } else {
        PG8_STAGE(PG8_SB(0, 0), cB, voffB); PG8_STAGE(PG8_SA(0, 0), cA, voffA); PG8_STAGE(PG8_SB(0, 1), cB + hstep, voffB); PG8_STAGE(PG8_SA(0, 1), cA + hstep, voffA);
        if (wr == 1) PG8_BAR;
        PG8_WAIT_V(4); PG8_BAR;
        PG8_STAGE(PG8_SB(1, 0), cB + kstep, voffB); PG8_STAGE(PG8_SA(1, 0), cA + kstep, voffA); PG8_STAGE(PG8_SB(1, 1), cB + hstep + kstep, voffB);
        PG8_WAIT_V(6); PG8_BAR;
    }
    for (;;) {
        const bool has_next = S.next(ui + 1, nxt);
        const char* nA = has_next ? (const char*)g.A + (size_t)nxt.pm * tstep : cA; const char* nB = has_next ? (const char*)g.Bt + (size_t)nxt.pn * tstep : cB;
        for (int t = 0; t < nt; t += 2) {
            const bool last = (t == nt - 2);
            const char* a1 = cA + (size_t)(t + 1) * kstep;
            const char* a2 = last ? nA : cA + (size_t)(t + 2) * kstep; const char* b2 = last ? nB : cB + (size_t)(t + 2) * kstep;
            const char* a3 = a2 + kstep; const char* b3 = b2 + kstep;
            if (last && has_next) S.a_ready(nxt);
            if constexpr (SP2) {
            PG8_LDB(B0, 0, 0); PG8_LDB(B1, 0, 1); PG8_SCHED; PG8_LDA(At, 0, 0); PG8_STAGE(PG8_SA(1, 1), a1 + hstep, voffA);
            PG8_WAIT_V(8); PG8_WAIT_L(0); PG8_BAR; PG8_MMA(0, 0, At, B0); PG8_MMA(0, 1, At, B1); PG8_BAR; PG8_SCHED;
            PG8_LDA(At, 0, 1); PG8_STAGE(PG8_SB(0, 0), b2, voffB); PG8_STAGE(PG8_SB(0, 1), b2 + hstep, voffB); PG8_STAGE(PG8_SA(0, 0), a2, voffA);
            PG8_WAIT_V(8); PG8_WAIT_L(0); PG8_BAR; PG8_MMA(1, 0, At, B0); PG8_MMA(1, 1, At, B1); PG8_BAR; PG8_SCHED;
            PG8_LDB(B0, 1, 0); PG8_LDB(B1, 1, 1); PG8_SCHED; PG8_LDA(At, 1, 0); PG8_STAGE(PG8_SA(0, 1), a2 + hstep, voffA);
            PG8_WAIT_V(8); PG8_WAIT_L(0); PG8_BAR; PG8_MMA(0, 0, At, B0); PG8_MMA(0, 1, At, B1); PG8_BAR; PG8_SCHED;
            PG8_LDA(At, 1, 1); PG8_STAGE(PG8_SB(1, 0), b3, voffB); PG8_STAGE(PG8_SB(1, 1), b3 + hstep, voffB); PG8_STAGE(PG8_SA(1, 0), a3, voffA);
            PG8_WAIT_V(8); PG8_WAIT_L(0); PG8_BAR; PG8_MMA(1, 0, At, B0); PG8_MMA(1, 1, At, B1); PG8_BAR; PG8_SCHED;
            } else {
            PG8_LDB(B0, 0, 0); PG8_SCHED; PG8_LDA(At, 0, 0); PG8_STAGE(PG8_SA(1, 1), a1 + hstep, voffA);
            PG8_WAIT_L(8); PG8_BAR; PG8_WAIT_L(0); PG8_MMA(0, 0, At, B0); PG8_BAR; PG8_SCHED;
            PG8_LDB(B1, 0, 1); PG8_STAGE(PG8_SB(0, 0), b2, voffB);
            PG8_BAR; PG8_WAIT_L(0); PG8_MMA(0, 1, At, B1); PG8_BAR;
            PG8_LDA(At, 0, 1); PG8_STAGE(PG8_SA(0, 0), a2, voffA);
            PG8_BAR; PG8_WAIT_L(0); PG8_MMA(1, 0, At, B0); PG8_BAR; PG8_SCHED;
            PG8_STAGE(PG8_SB(0, 1), b2 + hstep, voffB);
            PG8_WAIT_V(6); PG8_BAR; PG8_MMA(1, 1, At, B1); PG8_BAR;
            PG8_LDB(B0, 1, 0); PG8_SCHED; PG8_LDA(At, 1, 0); PG8_STAGE(PG8_SA(0, 1), a2 + hstep, voffA);
            PG8_WAIT_L(8); PG8_BAR; PG8_WAIT_L(0); PG8_MMA(0, 0, At, B0); PG8_BAR; PG8_SCHED;
            PG8_LDB(B1, 1, 1); PG8_STAGE(PG8_SB(1, 0), b3, voffB);
            PG8_BAR; PG8_WAIT_L(0); PG8_MMA(0, 1, At, B1); PG8_BAR;
            PG8_LDA(At, 1, 1); PG8_STAGE(PG8_SA(1, 0), a3, voffA);
            PG8_BAR; PG8_WAIT_L(0); PG8_MMA(1, 0, At, B0); PG8_BAR; PG8_SCHED;
            PG8_STAGE(PG8_SB(1, 1), b3 + hstep, voffB);
            PG8_WAIT_V(6); PG8_BAR; PG8_MMA(1, 1, At, B1); PG8_BAR;
            }
        }
        if constexpr (ALIGN_EPI) { if (wr == 0) PG8_BAR; }
        if constexpr (!Epi::AFTER_DRAIN) { E(acc, cur, wr, wc, fr, fq, prew); S.done(cur); }
        if (!has_next) break;
#pragma unroll
        for (int a = 0; a < 2; ++a)
#pragma unroll
            for (int b = 0; b < 2; ++b)
#pragma unroll
                for (int m = 0; m < 4; ++m)
#pragma unroll
                    for (int n = 0; n < 2; ++n) acc[a][b][m][n] = (f32x4){0.f, 0.f, 0.f, 0.f};
        cur = nxt; cA = nA; cB = nB; ++ui;
        E.pre(cur, wr, fr, prew);
        if constexpr (ALIGN_EPI) { if (wr == 1) PG8_BAR; }
    }
    PG8_WAIT_V(0);
    if constexpr (!ALIGN_EPI) { if (wr == 0) PG8_BAR; }
    PG8_BAR;
    if constexpr (Epi::AFTER_DRAIN) { E.fused(acc, cur, wr, wc, fr, fq, lds, wid, lane); S.done(cur); }
#undef PG8_SA
#undef PG8_SB
#undef PG8_STAGE
#undef PG8_LDA
#undef PG8_LDB
#undef PG8_MMA
#undef PG8_WAIT_V
#undef PG8_WAIT_L
#undef PG8_BAR
#undef PG8_SCHED
}
}
#include <hip/hip_bf16.h>
#include <cmath>
namespace attn_body {
using bf16=__hip_bfloat16;
using bf16x8=__attribute__((ext_vector_type(8)))short;
using s16x4=__attribute__((ext_vector_type(4)))short;
using f32x16=__attribute__((ext_vector_type(16)))float;
using u32x4=__attribute__((ext_vector_type(4)))unsigned;
using f32x4_t=__attribute__((ext_vector_type(4)))float;
constexpr int BATCH=4,NHEAD=16,SEQ=8192,D=64,DM=NHEAD*D;
constexpr int NW=8,QBLK=32,QB=QBLK*NW,KVBLK=64,NQB=SEQ/QB;
constexpr int ATTN_PITCH=DM, ATTN_UNIT_ROWS=QB;
__device__ __forceinline__ int crow(int r,int hi){return (r&3)+8*(r>>2)+4*hi;}
#define SBAR() __builtin_amdgcn_sched_barrier(0)
__device__ __forceinline__ void cmask(f32x16&p0,f32x16&p1,int jb,int qrel,int hi){
  const float NEG=-INFINITY; int kb=64*jb+4*hi;
  #pragma unroll
  for(int r=0;r<16;++r){int kv=kb+(r&3)+8*(r>>2); if(kv>qrel)p0[r]=NEG; if(kv+32>qrel)p1[r]=NEG;}
}

constexpr int NSLOT=3, SLOTB=8192;
constexpr int LDS_K=0, LDS_V=NSLOT*SLOTB, LDS_WS=2*NSLOT*SLOTB, LDS_OST=LDS_WS+NW*64*4, LDS_BI=LDS_OST+NW*4096, LDS_BYTES=LDS_BI+NW*NSLOT*256;
constexpr float C2=0.125f*1.4426950408889634f;
__device__ __forceinline__ void glds16(const void*gsrc,unsigned lds_dst){unsigned keep;
  asm volatile("s_mov_b32 %0, m0\n\ts_mov_b32 m0, %2\n\ts_nop 0\n\tglobal_load_lds_dwordx4 %1, off\n\ts_mov_b32 m0, %0":"=&s"(keep):"v"(gsrc),"s"(lds_dst):"memory");}
__device__ __forceinline__ void glds4(const void*gsrc,unsigned lds_dst){unsigned keep;
  asm volatile("s_mov_b32 %0, m0\n\ts_mov_b32 m0, %2\n\ts_nop 0\n\tglobal_load_lds_dword %1, off\n\ts_mov_b32 m0, %0":"=&s"(keep):"v"(gsrc),"s"(lds_dst):"memory");}
__device__ __forceinline__ void glds16s(const void*sbase,unsigned voff,unsigned lds_dst){unsigned keep;
  asm volatile("s_mov_b32 %0, m0\n\ts_mov_b32 m0, %3\n\ts_nop 0\n\tglobal_load_lds_dwordx4 %1, %2\n\ts_mov_b32 m0, %0":"=&s"(keep):"v"(voff),"s"(sbase),"s"(lds_dst):"memory");}
__device__ __forceinline__ void glds4s(const void*sbase,unsigned voff,unsigned lds_dst){unsigned keep;
  asm volatile("s_mov_b32 %0, m0\n\ts_mov_b32 m0, %3\n\ts_nop 0\n\tglobal_load_lds_dword %1, %2\n\ts_mov_b32 m0, %0":"=&s"(keep):"v"(voff),"s"(sbase),"s"(lds_dst):"memory");}
__device__ __forceinline__ float max3f(float a,float b,float c){float r;asm("v_max3_f32 %0, %1, %2, %3":"=v"(r):"v"(a),"v"(b),"v"(c));return r;}
__device__ __forceinline__ float max2f(float a,float b){float r;asm("v_max_f32_e32 %0, %1, %2":"=v"(r):"v"(a),"v"(b));return r;}
__device__ __forceinline__ float fadd_s(float a,float b){float r;asm("v_add_f32_e32 %0, %1, %2":"=v"(r):"v"(a),"v"(b));return r;}
__device__ __forceinline__ float fsub_s(float a,float b){float r;asm("v_sub_f32_e32 %0, %1, %2":"=v"(r):"v"(a),"v"(b));return r;}
typedef float f32x2_t __attribute__((ext_vector_type(2))); typedef __bf16 bf16x2_t __attribute__((ext_vector_type(2)));
__device__ __forceinline__ unsigned cvtpk_s(float lo,float hi){f32x2_t v={lo,hi};bf16x2_t b=__builtin_convertvector(v,bf16x2_t);return __builtin_bit_cast(unsigned,b);}
#define WAIT_BAR(N) asm volatile("s_waitcnt vmcnt(" #N ") lgkmcnt(0)\n\ts_barrier":::"memory")

__device__ __forceinline__ void qkt(f32x16&p0,f32x16&p1,const char*Kslot,const bf16x8*qr,int r32,int hi){
  const char*kb=Kslot+hi*1024+r32*16;
  #pragma unroll
  for(int d0=0;d0<4;++d0){
    const bf16x8 b0=*reinterpret_cast<const bf16x8*>(kb+d0*2048);
    const bf16x8 b1=*reinterpret_cast<const bf16x8*>(kb+d0*2048+512);
    {p0=__builtin_amdgcn_mfma_f32_32x32x16_bf16(b0,qr[d0],p0,0,0,0);p1=__builtin_amdgcn_mfma_f32_32x32x16_bf16(b1,qr[d0],p1,0,0,0);}}
}
typedef __attribute__((address_space(3))) const char* lds_cptr;
typedef short v4i16_t __attribute__((ext_vector_type(4)));
__device__ __forceinline__ void kload8(bf16x8*kf,lds_cptr kp){
  kf[0]=*(const __attribute__((address_space(3))) bf16x8*)(kp);      kf[1]=*(const __attribute__((address_space(3))) bf16x8*)(kp+512);
  kf[2]=*(const __attribute__((address_space(3))) bf16x8*)(kp+2048); kf[3]=*(const __attribute__((address_space(3))) bf16x8*)(kp+2560);
  kf[4]=*(const __attribute__((address_space(3))) bf16x8*)(kp+4096); kf[5]=*(const __attribute__((address_space(3))) bf16x8*)(kp+4608);
  kf[6]=*(const __attribute__((address_space(3))) bf16x8*)(kp+6144); kf[7]=*(const __attribute__((address_space(3))) bf16x8*)(kp+6656);
}
__device__ __forceinline__ void kload2(bf16x8*kf,lds_cptr kp,int j){ kf[2*j]=*(const __attribute__((address_space(3))) bf16x8*)(kp+j*2048); kf[2*j+1]=*(const __attribute__((address_space(3))) bf16x8*)(kp+j*2048+512); }
__device__ __forceinline__ s16x4 vtr(lds_cptr p){ return __builtin_bit_cast(s16x4,__builtin_amdgcn_ds_read_tr16_b64_v4i16((__attribute__((address_space(3))) v4i16_t*)p)); }
__device__ __forceinline__ float rowmax(const f32x16&p0,const f32x16&p1){
  float a=max3f(p0[0],p0[1],p1[0]),b=max3f(p0[2],p0[3],p1[1]);a=max3f(a,p1[2],p1[3]);
  #pragma unroll
  for(int r=4;r<16;r+=4){a=max3f(a,p0[r],p0[r+1]);b=max3f(b,p0[r+2],p0[r+3]);a=max3f(a,p1[r],p1[r+1]);b=max3f(b,p1[r+2],p1[r+3]);}
  const float m=max2f(a,b);
  auto rr=__builtin_amdgcn_permlane32_swap(__float_as_uint(m),__float_as_uint(m),false,false);
  return max2f(__uint_as_float(rr[0]),__uint_as_float(rr[1]));
}
__device__ __forceinline__ void pv(f32x16*o,int vb,bf16x8 pa0,bf16x8 pa1,bf16x8 pa2,bf16x8 pa3){
  #pragma unroll
  for(int d0=0;d0<2;++d0){s16x4 lo[4],hi[4];
    #pragma unroll
    for(int ks=0;ks<4;++ks){
      asm volatile("ds_read_b64_tr_b16 %0,%1 offset:%c2":"=&v"(lo[ks]):"v"(vb),"i"(d0*4096+ks*1024):"memory");
      asm volatile("ds_read_b64_tr_b16 %0,%1 offset:%c2":"=&v"(hi[ks]):"v"(vb),"i"(d0*4096+ks*1024+512):"memory");}
    asm volatile("s_waitcnt lgkmcnt(0)":::"memory");SBAR();
    #define PK(k) (bf16x8){lo[k][0],lo[k][1],lo[k][2],lo[k][3],hi[k][0],hi[k][1],hi[k][2],hi[k][3]}
    o[d0]=__builtin_amdgcn_mfma_f32_32x32x16_bf16(pa0,PK(0),o[d0],0,0,0);
    o[d0]=__builtin_amdgcn_mfma_f32_32x32x16_bf16(pa1,PK(1),o[d0],0,0,0);
    o[d0]=__builtin_amdgcn_mfma_f32_32x32x16_bf16(pa2,PK(2),o[d0],0,0,0);
    o[d0]=__builtin_amdgcn_mfma_f32_32x32x16_bf16(pa3,PK(3),o[d0],0,0,0);
    #undef PK
  }
}

#ifndef ATTN_STORE16
#define ATTN_STORE16(p,v) (*(u32x4*)(p)=(v))
#endif
template<int THRL> __device__ __forceinline__ void attn_unit(int b,int h,int qb,const bf16*Q,const bf16*__restrict__ K,const bf16*__restrict__ V,const bf16*__restrict__ G,const float*__restrict__ CB,float moff,int t0,bf16*O,char*shm){
  const int tid=mk_tid(),lane=tid&63,r32=lane&31,hi=lane>>5; const int wid=__builtin_amdgcn_readfirstlane(tid>>6);
  const long rowbase=(long)b*SEQ; const int q0=qb*QB;
  const bf16*Qw=Q+(rowbase+q0+wid*QBLK)*DM+h*D;
  const bf16*Kh=K+(rowbase+(long)t0*KVBLK)*DM+h*D,*Vh=V+(rowbase+(long)t0*KVBLK)*DM+h*D;
  const unsigned lds0=(unsigned)(uintptr_t)shm;
  const unsigned koff=(unsigned)(lane*DM+wid*8)*2u;
  const unsigned voff=(unsigned)((16*(wid&3)+(lane>>2))*DM+(wid>>2)*32+(lane&3)*8)*2u;
  const float*CBh=CB+((long)b*NHEAD+h)*SEQ; const unsigned boff=(unsigned)lane*4u;
  const unsigned kdst=lds0+LDS_K+wid*1024, vdst=lds0+LDS_V+wid*1024, bdst=lds0+LDS_BI+wid*(NSLOT*256);
  #define DMA_K(t,slot) do{ glds16s(Kh+(long)(t)*KVBLK*DM,koff,(unsigned)__builtin_amdgcn_readfirstlane(kdst+(slot))); glds4s(CBh+(long)((t)+t0)*KVBLK,boff,(unsigned)__builtin_amdgcn_readfirstlane(bdst+((slot)>>5))); }while(0)
  #define DMA_V(t,slot) glds16s(Vh+(long)(t)*KVBLK*DM,voff,(unsigned)__builtin_amdgcn_readfirstlane(vdst+(slot)))
  const char*Kbase=shm+LDS_K; bf16x8 kf[8];
  const lds_cptr shm3=(lds_cptr)shm; const lds_cptr kp0=shm3+LDS_K+hi*1024+r32*16; const lds_cptr vp0=shm3+LDS_V+((lane>>4)&1)*32+(lane&3)*8+(4*hi+((lane&15)>>2))*64;
  const int NT=(q0+QB)/KVBLK-t0;
  DMA_K(0,0);DMA_V(0,0);DMA_K(1,SLOTB);
  bf16x8 qr[4];
  #pragma unroll
  for(int d0=0;d0<4;++d0)qr[d0]=*reinterpret_cast<const bf16x8*>(&Qw[(long)r32*DM+d0*16+hi*8]);
  float l_reg=0.f;f32x16 o[2];o[0]=f32x16{};o[1]=f32x16{};
  const float cqm=CBh[q0+wid*QBLK+r32]-moff;
  typedef __attribute__((address_space(3))) const f32x4_t* lds_f4p;
  const lds_cptr bp0=(lds_cptr)shm+LDS_BI+wid*(NSLOT*256)+hi*16;
  #define BIAS_RD(P0,P1,sl) do{ const lds_f4p bq_=(lds_f4p)(bp0+((sl)>>5)); \
    _Pragma("unroll") for(int a_=0;a_<4;++a_){ const f32x4_t x0_=bq_[2*a_]; P0[4*a_]=x0_[0];P0[4*a_+1]=x0_[1];P0[4*a_+2]=x0_[2];P0[4*a_+3]=x0_[3]; } \
    _Pragma("unroll") for(int a_=0;a_<4;++a_){ const f32x4_t x1_=bq_[8+2*a_]; P1[4*a_]=x1_[0];P1[4*a_+1]=x1_[1];P1[4*a_+2]=x1_[2];P1[4*a_+3]=x1_[3]; } \
    asm volatile("":"+v"(P0),"+v"(P1)); }while(0)
  #define BIAS_SUB(P0,P1) do{ _Pragma("unroll") for(int r_=0;r_<16;++r_){ P0[r_]=cqm-P0[r_]; P1[r_]=cqm-P1[r_]; } }while(0)
  #define BIAS_LD(P0,P1,sl) do{ BIAS_RD(P0,P1,sl); BIAS_SUB(P0,P1); }while(0)
  #define CMASK(P0,P1,t) do{int jb_=(t)-(NT-4); if(jb_>=0){ int ln_=mk_tid()&63; asm volatile("":"+v"(ln_)); cmask(P0,P1,jb_,wid*QBLK+(ln_&31),ln_>>5);} }while(0)
  f32x16 pA0,pA1,pB0,pB1;
  int sl_prev=0,sl_cur=0,sl_next=SLOTB;
  #define ROT() do{sl_prev=sl_cur;sl_cur=sl_next;sl_next=(sl_next==(NSLOT-1)*SLOTB)?0:sl_next+SLOTB;}while(0)
  DMA_K(2,2*SLOTB);
  WAIT_BAR(5);
  BIAS_LD(pA0,pA1,0);
  qkt(pA0,pA1,Kbase,qr,r32,hi);asm volatile("s_nop 15\n\ts_nop 7":"+v"(pA0),"+v"(pA1));CMASK(pA0,pA1,0);
  _Pragma("unroll") for(int r=0;r<16;++r)pA0[r]=__builtin_amdgcn_exp2f(pA0[r]);
  _Pragma("unroll") for(int r=0;r<16;++r)pA1[r]=__builtin_amdgcn_exp2f(pA1[r]);
  WAIT_BAR(0);
  DMA_K(3,0);DMA_V(1,SLOTB);
  ROT();
  kload8(kf,kp0+sl_cur);
  BIAS_RD(pB0,pB1,sl_cur);
  WAIT_BAR(3);
  s16x4 vlo[8],vhi[8]; u32x4 pw0,pw1,pw2,pw3;
  #define PKW(P,B) cvtpk_s(P[B],P[B+1])
  #define PAF(k) __builtin_bit_cast(bf16x8,pw##k)
  #define VFR(i) (bf16x8){vlo[i][0],vlo[i][1],vlo[i][2],vlo[i][3],vhi[i][0],vhi[i][1],vhi[i][2],vhi[i][3]}
  #define PIN(x) asm volatile("":"+v"(x))
  #define MX3(a,b,c) __builtin_fmaxf(__builtin_fmaxf((a),(b)),(c))
  #define GAPA(MF,A0,A1,A2,A3,W0,W1,PW) do{ MF; sacc+=A0; sacc+=A1; sacc+=A2; sacc+=A3; PIN(sacc); W0; W1; PIN(PW); SBAR(); }while(0)
  #define EX(v) __builtin_amdgcn_exp2f(v)
  #define GAPB(MF,X,B) do{ MF; X[B]=EX(X[B]); X[B+1]=EX(X[B+1]); X[B+2]=EX(X[B+2]); X[B+3]=EX(X[B+3]); PIN(X); SBAR(); }while(0)
  #define VRD(i) do{ vlo[i]=vtr(vp_+(((i)>>2)*4096+((i)&3)*1024)); vhi[i]=vtr(vp_+(((i)>>2)*4096+((i)&3)*1024+512)); }while(0)
  #define KRD(G,j) do{ if(G){ kload2(kf,kp0+sl_next,j); SBAR(); } }while(0)
  #define STEP(C0,C1,P0,P1,t,GK,GV,GL) do{ SBAR(); BIAS_SUB(C0,C1); SBAR(); \
    const lds_cptr vp_=vp0+sl_prev; \
    VRD(0); SBAR(); float sacc=(P0[0]+P0[1]); \
    GAPA(C0=__builtin_amdgcn_mfma_f32_32x32x16_bf16(kf[0],qr[0],C0,0,0,0), P0[2],P0[3],P0[4],P0[5],     pw0[0]=PKW(P0,0), pw0[1]=PKW(P0,2), pw0); \
    VRD(4); SBAR(); GAPA(C1=__builtin_amdgcn_mfma_f32_32x32x16_bf16(kf[1],qr[0],C1,0,0,0), P0[6],P0[7],P0[8],P0[9],     pw0[2]=PKW(P0,4), pw0[3]=PKW(P0,6), pw0); \
    VRD(1); SBAR(); GAPA(C0=__builtin_amdgcn_mfma_f32_32x32x16_bf16(kf[2],qr[1],C0,0,0,0),   P0[10],P0[11],P0[12],P0[13], pw1[0]=PKW(P0,8), pw1[1]=PKW(P0,10), pw1); \
    VRD(5); SBAR(); GAPA(C1=__builtin_amdgcn_mfma_f32_32x32x16_bf16(kf[3],qr[1],C1,0,0,0),   P0[14],P0[15],P1[0],P1[1],   pw1[2]=PKW(P0,12),pw1[3]=PKW(P0,14), pw1); \
    VRD(2); SBAR(); GAPA(C0=__builtin_amdgcn_mfma_f32_32x32x16_bf16(kf[4],qr[2],C0,0,0,0),   P1[2],P1[3],P1[4],P1[5],     pw2[0]=PKW(P1,0), pw2[1]=PKW(P1,2), pw2); \
    VRD(6); SBAR(); GAPA(C1=__builtin_amdgcn_mfma_f32_32x32x16_bf16(kf[5],qr[2],C1,0,0,0),   P1[6],P1[7],P1[8],P1[9],     pw2[2]=PKW(P1,4), pw2[3]=PKW(P1,6), pw2); \
    VRD(3); SBAR(); GAPA(C0=__builtin_amdgcn_mfma_f32_32x32x16_bf16(kf[6],qr[3],C0,0,0,0),   P1[10],P1[11],P1[12],P1[13], pw3[0]=PKW(P1,8), pw3[1]=PKW(P1,10), pw3); \
    VRD(7); SBAR(); GAPA(C1=__builtin_amdgcn_mfma_f32_32x32x16_bf16(kf[7],qr[3],C1,0,0,0),   P1[14],P1[15],0.f,0.f,       pw3[2]=PKW(P1,12),pw3[3]=PKW(P1,14), pw3); \
    l_reg+=sacc; \
    if(GK){DMA_K((t)+3,sl_cur);} if(GV){DMA_V((t)+1,sl_next);} \
    CMASK(C0,C1,t); \
    SBAR(); \
    GAPB(o[0]=__builtin_amdgcn_mfma_f32_32x32x16_bf16(PAF(0),VFR(0),o[0],0,0,0), C0,0); \
    GAPB(o[1]=__builtin_amdgcn_mfma_f32_32x32x16_bf16(PAF(0),VFR(4),o[1],0,0,0), C0,4); \
    KRD(GL,0); GAPB(o[0]=__builtin_amdgcn_mfma_f32_32x32x16_bf16(PAF(1),VFR(1),o[0],0,0,0), C0,8); \
    KRD(GL,1); GAPB(o[1]=__builtin_amdgcn_mfma_f32_32x32x16_bf16(PAF(1),VFR(5),o[1],0,0,0), C0,12); \
    KRD(GL,2); GAPB(o[0]=__builtin_amdgcn_mfma_f32_32x32x16_bf16(PAF(2),VFR(2),o[0],0,0,0), C1,0); \
    KRD(GL,3); GAPB(o[1]=__builtin_amdgcn_mfma_f32_32x32x16_bf16(PAF(2),VFR(6),o[1],0,0,0), C1,4); \
    GAPB(o[0]=__builtin_amdgcn_mfma_f32_32x32x16_bf16(PAF(3),VFR(3),o[0],0,0,0), C1,8); \
    GAPB(o[1]=__builtin_amdgcn_mfma_f32_32x32x16_bf16(PAF(3),VFR(7),o[1],0,0,0), C1,12); \
    if(GL){ BIAS_RD(P0,P1,sl_next); } \
    }while(0)
  int t=1;
  #undef CMASK
  #define CMASK(P0,P1,t) do{}while(0)
  for(;t+5<NT;t+=2){
    STEP(pB0,pB1,pA0,pA1,t,true,true,true);     WAIT_BAR(3); ROT();
    STEP(pA0,pA1,pB0,pB1,t+1,true,true,true);   WAIT_BAR(3); ROT();
  }
  #undef CMASK
  #define CMASK(P0,P1,t) do{int jb_=(t)-(NT-4); if(jb_>=0){ int ln_=mk_tid()&63; asm volatile("":"+v"(ln_)); cmask(P0,P1,jb_,wid*QBLK+(ln_&31),ln_>>5);} }while(0)
  #define ENDW(tt) do{ if((tt)+3<NT){WAIT_BAR(3);} else if((tt)+2<NT){WAIT_BAR(1);} else {WAIT_BAR(0);} }while(0)
  for(;t+1<NT;t+=2){
    STEP(pB0,pB1,pA0,pA1,t,(t+3<NT),(t+1<NT),(t+1<NT));       ENDW(t);   ROT();
    STEP(pA0,pA1,pB0,pB1,t+1,(t+4<NT),(t+2<NT),(t+2<NT));     ENDW(t+1); ROT();
  }
  STEP(pB0,pB1,pA0,pA1,NT-1,false,false,false);
  { float sacc=pB0[0]+pB0[1]; _Pragma("unroll") for(int r=2;r<16;++r)sacc+=pB0[r]; _Pragma("unroll") for(int r=0;r<16;++r)sacc+=pB1[r]; l_reg+=sacc;
    pw0=(u32x4){PKW(pB0,0),PKW(pB0,2),PKW(pB0,4),PKW(pB0,6)};pw1=(u32x4){PKW(pB0,8),PKW(pB0,10),PKW(pB0,12),PKW(pB0,14)};pw2=(u32x4){PKW(pB1,0),PKW(pB1,2),PKW(pB1,4),PKW(pB1,6)};pw3=(u32x4){PKW(pB1,8),PKW(pB1,10),PKW(pB1,12),PKW(pB1,14)};
    int lane_v=mk_tid()&63; asm volatile("":"+v"(lane_v)); const int vb0=(int)(lds0+LDS_V)+((lane_v>>4)&1)*32+(lane_v&3)*8+(4*(lane_v>>5)+((lane_v&15)>>2))*64;
    SBAR(); pv(o,vb0+sl_cur,PAF(0),PAF(1),PAF(2),PAF(3)); }
  #undef PKW
  #undef PAF
  #undef VFR
  #undef PIN
  #undef MX3
  #undef GAPA
  #undef GAPB
  #undef EX
  #undef VRD
  #undef KRD
  #undef STEP
  #undef ENDW
  {auto rr=__builtin_amdgcn_permlane32_swap(__float_as_uint(l_reg),__float_as_uint(l_reg),false,false);l_reg=__uint_as_float(rr[0])+__uint_as_float(rr[1]);}
  float*wsf=(float*)(shm+LDS_WS)+wid*64;
  if(hi==0)wsf[32+r32]=l_reg;asm volatile("s_waitcnt lgkmcnt(0)":::"memory");
  float rli[16];
  #pragma unroll
  for(int r=0;r<16;++r)rli[r]=__builtin_amdgcn_rcpf(wsf[32+crow(r,hi)]);
  int qb_l=qb,b_l=b,h_l=h; asm volatile("":"+s"(qb_l),"+s"(b_l),"+s"(h_l)); int lane_l=mk_tid()&63; asm volatile("":"+v"(lane_l));
  const long eoff=((long)b_l*SEQ+qb_l*QB+wid*QBLK)*DM+h_l*D; bf16*Ow=O+eoff; const bf16*Gw=G+eoff;
  u32x4 gpre[4];
  #pragma unroll
  for(int i=0;i<4;++i)gpre[i]=*(const u32x4*)(Gw+(long)(i*8+(lane_l>>3))*DM+(lane_l&7)*8);
  { bf16*stg=(bf16*)(shm+LDS_OST)+wid*2048;
    #pragma unroll
    for(int r=0;r<16;++r){const int orow=crow(r,hi);
      #pragma unroll
      for(int d0=0;d0<2;++d0)stg[orow*64+d0*32+r32]=__float2bfloat16(o[d0][r]*rli[r]);}
    asm volatile("s_waitcnt lgkmcnt(0)":::"memory");
    #pragma unroll
    for(int i=0;i<4;++i){const int row=i*8+(lane_l>>3),ch=lane_l&7; u32x4 v=*(const u32x4*)(stg+row*64+ch*8); const u32x4 g=gpre[i];
      _Pragma("unroll") for(int e=0;e<4;++e){ const float a0=__uint_as_float(v[e]<<16)*__uint_as_float(g[e]<<16), a1=__uint_as_float(v[e]&0xffff0000u)*__uint_as_float(g[e]&0xffff0000u); v[e]=cvtpk_s(a0,a1); }
      ATTN_STORE16(Ow+(long)row*DM+ch*8,v);} }
  asm volatile("s_waitcnt lgkmcnt(0)\n\ts_barrier":::"memory");
  #undef DMA_K
  #undef DMA_V
  #undef CMASK
  #undef BIAS_LD
  #undef BIAS_RD
  #undef BIAS_SUB
  #undef ROT
}
constexpr int ATTN_LDS_BYTES=LDS_BYTES;
struct AttnTensors { const bf16* Q; const bf16* K; const bf16* V; const bf16* G; const float* CB; const float* gq; const float* gk; bf16* O; unsigned* queue; const unsigned* nrm; };
struct AttnUnit { int bh; int qb; };
struct StaticOrder {
  int vcu;
  __device__ __forceinline__ explicit StaticOrder(int grid,int block):vcu((block%8)*(grid/8)+block/8){}
  __device__ __forceinline__ bool next(int i,AttnUnit&u)const{ if(i>=8)return false; const int s=vcu&7,j=i&3; u.bh=(vcu>>3)+32*(i>>2); u.qb=(j==0)?s:(j==1)?15-s:(j==2)?16+s:31-s; return true; }
  __device__ __forceinline__ void a_ready(const AttnUnit&)const{}
  __device__ __forceinline__ void done(const AttnUnit&)const{}
};
template<class Sched,int THRL=8> __device__ __forceinline__ void attn_phase(char*lds,const AttnTensors&T,const Sched&S){
  AttnUnit u; const int lane_=mk_tid()&63;
  float ga=fabsf(T.gq[lane_]),gb=fabsf(T.gk[lane_]);
  #pragma unroll
  for(int o_=32;o_;o_>>=1){ga=fmaxf(ga,__shfl_xor(ga,o_));gb=fmaxf(gb,__shfl_xor(gb,o_));}
  const float moff=8.0f*1.4426950408889634f*ga*gb;
  volatile __attribute__((address_space(3))) unsigned* qw=(volatile __attribute__((address_space(3))) unsigned*)(lds+LDS_BYTES);
  const unsigned NU_=(unsigned)(BATCH*NHEAD*NQB);
  #define ATT_TICKET() __hip_atomic_fetch_add(T.queue,1u,__ATOMIC_RELAXED,__HIP_MEMORY_SCOPE_AGENT)
  unsigned pend=0u;
  if(mk_tid()==0){ qw[0]=ATT_TICKET(); qw[1]=ATT_TICKET(); pend=ATT_TICKET(); }
  __syncthreads();
  unsigned idx=qw[0], idxn=qw[1];
  #define ATT_OPERANDS(I,CQ,CA,CB_,NQ,NK) do{ const unsigned i_=(I)<NU_?(I):0u; const int qb_=NQB-1-(int)(i_/(BATCH*NHEAD)), bh_=(int)(i_%(BATCH*NHEAD)); const float* c_=T.CB+(long)bh_*SEQ; \
    CQ=c_[qb_*QB]; CA=c_[64*lane_+63]; CB_=c_[64*(lane_+64)+63]; NQ=__uint_as_float(T.nrm[bh_]); NK=__uint_as_float(T.nrm[64+bh_]); }while(0)
  float cq0,cA,cB,nq2,nk2; ATT_OPERANDS(idx,cq0,cA,cB,nq2,nk2);
  __syncthreads();
  for(;;){
    if(idx>=NU_) break;
    const int qb=NQB-1-(int)(idx/(BATCH*NHEAD)), bh=(int)(idx%(BATCH*NHEAD)), ntf=4*qb+4;
    const float lim=__builtin_amdgcn_exp2f(-26.0f-2.02f*__builtin_sqrtf(nq2*nk2));
    float eA=(lane_<ntf)?__builtin_amdgcn_exp2f(cq0-cA):0.f, eB=(lane_+64<ntf)?__builtin_amdgcn_exp2f(cq0-cB):0.f;
    #pragma unroll
    for(int o_=1;o_<64;o_<<=1){ const float a_=__shfl_up(eA,o_), b_=__shfl_up(eB,o_); if(lane_>=o_){eA+=a_;eB+=b_;} }
    eB+=__shfl(eA,63);
    const bool s0=(lane_<ntf)&(eA<=lim), s1=(lane_+64<ntf)&(eB<=lim);
    int t0=__popcll(__ballot(s0))+__popcll(__ballot(s1)); t0&=~1; if(t0>ntf-4)t0=ntf-4;
    ATT_OPERANDS(idxn,cq0,cA,cB,nq2,nk2);
    attn_unit<THRL>(bh/NHEAD,bh%NHEAD,qb,T.Q,T.K,T.V,T.G,T.CB,moff,t0,T.O,lds);
    if(mk_tid()==0){ qw[0]=pend; pend=ATT_TICKET(); }
    asm volatile("s_waitcnt lgkmcnt(0)\n\ts_barrier":::"memory");
    idx=idxn; idxn=qw[0];
  }
  #undef ATT_TICKET
  #undef ATT_OPERANDS
}
#undef SBAR
#undef WAIT_BAR
}
constexpr int NWAVES = 8;
constexpr int BATCH = 4, SEQ = 8192, D = 1024, FF = 4096, M = BATCH * SEQ;
constexpr int N0P = 3072, N1P = 4096;
constexpr int GH = 4, GDK = 128, GDV = 256, GC = 64, GNC = SEQ / GC, GUNITS = BATCH * GH * GNC;
constexpr float EPS = 1e-6f, LOG2E = 1.4426950408889634f;
constexpr size_t MiB = 1u << 20;
constexpr size_t WS_RSTD0 = 1 * MiB, WS_SSQ = 1 * MiB + 131072  , WS_LF = 2 * MiB, WS_CB = 4 * MiB, WS_DEC = 6 * MiB, WS_GLB = 7 * MiB  , WS_WG0 = 8 * MiB  , WS_WF1 = 8 * MiB + 65536;
constexpr size_t WS_WIN0 = 12 * MiB, WS_WOUT0 = 19 * MiB, WS_W1A = 21 * MiB, WS_W2A = 29 * MiB, WS_WIN1 = 37 * MiB, WS_WOUT1 = 46 * MiB, WS_W1B = 48 * MiB, WS_W2B = 56 * MiB;
constexpr size_t WS_XB = 64 * MiB, WS_PH = 128 * MiB, WS_PROJ0 = WS_PH, WS_Y0 = 336 * MiB, WS_U = WS_PH, WS_Q = 128 * MiB, WS_K = 192 * MiB, WS_V = 256 * MiB, WS_G = 320 * MiB, WS_O = 384 * MiB, WS_END = 448 * MiB;
constexpr int RING_BYTES = 131072, LDS_BYTES = 147456;
#define LAS __attribute__((address_space(3)))
typedef unsigned short bf16;
typedef unsigned v4u __attribute__((ext_vector_type(4)));
typedef unsigned v2u __attribute__((ext_vector_type(2)));
typedef float f32x4 __attribute__((ext_vector_type(4)));
typedef short bf16x8 __attribute__((ext_vector_type(8)));
typedef short s16x4 __attribute__((ext_vector_type(4)));
#define LDS_WAIT() asm volatile("s_waitcnt lgkmcnt(0)" ::: "memory")
typedef float f32x2_hw __attribute__((ext_vector_type(2))); typedef __bf16 bf16x2_hw __attribute__((ext_vector_type(2)));
__device__ __forceinline__ unsigned pk2(float lo, float hi) { const f32x2_hw v = {lo, hi}; return __builtin_bit_cast(unsigned, __builtin_convertvector(v, bf16x2_hw)); }
__device__ __forceinline__ unsigned f2bf(float f) { return pk2(f, 0.f) & 0xffffu; }
__device__ __forceinline__ float frcp(float x) { return __builtin_amdgcn_rcpf(x); }
__device__ __forceinline__ float frsq(float x) { return __builtin_amdgcn_rsqf(x); }
__device__ __forceinline__ float bf2f(bf16 v) { return __uint_as_float((unsigned)v << 16); }
__device__ __forceinline__ float bflo(unsigned w) { return __uint_as_float(w << 16); }
__device__ __forceinline__ float bfhi(unsigned w) { return __uint_as_float(w & 0xffff0000u); }
__device__ __forceinline__ float wave_sum(float v) {
#pragma unroll
    for (int o = 1; o < 64; o <<= 1) v += __shfl_xor(v, o);
    return v;
}
__device__ __forceinline__ float fexp(float x) { return __builtin_amdgcn_exp2f(x * 1.4426950408889634f); }
__device__ __forceinline__ float log_sigmoid(float z) { return fminf(z, 0.f) - __logf(1.0f + fexp(-fabsf(z))); }

struct Args { const float* in[20]; float* out; unsigned char* ws; int ph_lo, ph_hi; };
struct Frame { LAS unsigned char* lds; int tid, lane, wave, vcu, G; };

__device__ __forceinline__ int col_src(int mode, int c, int Norig) {
    if (mode == 0) return c < Norig ? c : -1;
    if (mode == 2) return c < 16 ? 3072 + c : -1;
    return c < 3072 ? c : (c < 4096 ? c + 16 : (c < 4112 ? c - 1024 : -1));
}
__device__ __forceinline__ void p0_transpose_item(const float* W, int K, int Norig, int Npad, int mode, const float* gain, bf16* WT, LAS float* scr, int item, int lane) {
    const int nblk = Npad / 32, kb = item / nblk, nb = item % nblk, k0 = 64 * kb, n0 = 32 * nb;
    const int c4 = lane & 7, sc = col_src(mode, n0 + 4 * c4, Norig);
    f32x4 v[8]; float gk[8];
    const char* wb = (const char*)(W + (size_t)k0 * Norig); const unsigned wo = (unsigned)((lane >> 3) * Norig + (sc >= 0 ? sc : 0)) * 4u;
    const float* gp = gain ? gain + k0 : W;
#pragma unroll
    for (int i = 0; i < 8; ++i) { v[i] = *(const f32x4*)(wb + (size_t)(8 * i) * Norig * 4 + wo); gk[i] = gp[8 * i + (lane >> 3)]; }
#pragma unroll
    for (int i = 0; i < 8; ++i) { const int kk = 8 * i + (lane >> 3); f32x4 w = v[i]; const float gm = gain ? gk[i] : 1.0f; w = w * (sc >= 0 ? gm : 0.0f);
        LAS float* d = scr + kk * 33 + 4 * c4; d[0] = w[0]; d[1] = w[1]; d[2] = w[2]; d[3] = w[3]; }
    LDS_WAIT(); asm volatile("" ::: "memory");
    const int c = lane & 7;
    const int prow0 = (n0 & ~255) + 128 * ((n0 >> 5) & 1) + 32 * ((n0 >> 6) & 3);
#pragma unroll
    for (int j = 0; j < 4; ++j) { const int n = (lane >> 3) + 8 * j; const LAS float* s = scr + (8 * c) * 33 + n;
        v4u o; o.x = pk2(s[0 * 33], s[1 * 33]); o.y = pk2(s[2 * 33], s[3 * 33]); o.z = pk2(s[4 * 33], s[5 * 33]); o.w = pk2(s[6 * 33], s[7 * 33]);
        *(v4u*)(WT + (size_t)(prow0 + n) * K + k0 + 8 * c) = o; }
    LDS_WAIT(); asm volatile("" ::: "memory");
}
__device__ __forceinline__ void p0_prologue(Frame& F, const Args& a) {
    LAS float* scr = (LAS float*)(F.lds + F.wave * 16384);
    unsigned char* ws = a.ws;
    const int gw = F.vcu * NWAVES + F.wave, NGW = F.G * NWAVES;
    constexpr int I0 = (D / 64) * (N0P / 32), I1 = (D / 64) * (D / 32), I2 = (D / 64) * (FF / 32), I3 = (FF / 64) * (D / 32), I4 = (D / 64) * (N1P / 32);
    constexpr int IT = D / 64;
    constexpr int NITEMS = I0 + I1 + I2 + I3 + I4 + I1 + I2 + I3 + 2 * IT;
#pragma unroll 1
    for (int it = gw; it < NITEMS; it += NGW) {
        int r = it;
        if (r < I0) { p0_transpose_item(a.in[2], D, 3088, N0P, 0, a.in[1], (bf16*)(ws + WS_WIN0), scr, r, F.lane); continue; } r -= I0;
        if (r < I1) { p0_transpose_item(a.in[6], D, D, D, 0, nullptr, (bf16*)(ws + WS_WOUT0), scr, r, F.lane); continue; } r -= I1;
        if (r < I2) { p0_transpose_item(a.in[8], D, FF, FF, 0, a.in[7], (bf16*)(ws + WS_W1A), scr, r, F.lane); continue; } r -= I2;
        if (r < I3) { p0_transpose_item(a.in[9], FF, D, D, 0, nullptr, (bf16*)(ws + WS_W2A), scr, r, F.lane); continue; } r -= I3;
        if (r < I4) { p0_transpose_item(a.in[11], D, 4112, N1P, 1, a.in[10], (bf16*)(ws + WS_WIN1), scr, r, F.lane); continue; } r -= I4;
        if (r < I1) { p0_transpose_item(a.in[15], D, D, D, 0, nullptr, (bf16*)(ws + WS_WOUT1), scr, r, F.lane); continue; } r -= I1;
        if (r < I2) { p0_transpose_item(a.in[17], D, FF, FF, 0, a.in[16], (bf16*)(ws + WS_W1B), scr, r, F.lane); continue; } r -= I2;
        if (r < I3) { p0_transpose_item(a.in[18], FF, D, D, 0, nullptr, (bf16*)(ws + WS_W2B), scr, r, F.lane); continue; } r -= I3;
        if (r < IT) { p0_transpose_item(a.in[2], D, 3088, 32, 2, a.in[1], (bf16*)(ws + WS_WG0), scr, r, F.lane); continue; } r -= IT;
        p0_transpose_item(a.in[11], D, 4112, 32, 2, a.in[10], (bf16*)(ws + WS_WF1), scr, r, F.lane);
    }
    const float* x = a.in[0]; bf16* XB = (bf16*)(ws + WS_XB); float* rstd0 = (float*)(ws + WS_RSTD0);
    { int m = 2 * gw; f32x4 v[8];
      if (m < M) { const f32x4* xr = (const f32x4*)(x + (size_t)m * D) + F.lane;
#pragma unroll
          for (int j = 0; j < 8; ++j) v[j] = xr[64 * j]; }
#pragma unroll 1
      for (; m < M; m += 2 * NGW) { const int mn = m + 2 * NGW; f32x4 w[8];
          if (mn < M) { const f32x4* xn = (const f32x4*)(x + (size_t)mn * D) + F.lane;
#pragma unroll
              for (int j = 0; j < 8; ++j) w[j] = xn[64 * j]; }
          float s0 = 0.f, s1 = 0.f;
#pragma unroll
          for (int j = 0; j < 4; ++j) { s0 += (v[j].x * v[j].x + v[j].y * v[j].y) + (v[j].z * v[j].z + v[j].w * v[j].w); s1 += (v[4 + j].x * v[4 + j].x + v[4 + j].y * v[4 + j].y) + (v[4 + j].z * v[4 + j].z + v[4 + j].w * v[4 + j].w); }
          s0 = wave_sum(s0); s1 = wave_sum(s1);
          if (F.lane == 0) { rstd0[m] = frsq(s0 * (1.0f / D) + EPS); rstd0[m + 1] = frsq(s1 * (1.0f / D) + EPS); }
          v2u* o8 = (v2u*)(XB + (size_t)m * D) + F.lane;
#pragma unroll
          for (int j = 0; j < 8; ++j) { v2u pw; pw.x = pk2(v[j].x, v[j].y); pw.y = pk2(v[j].z, v[j].w); o8[64 * j] = pw; }
#pragma unroll
          for (int j = 0; j < 8; ++j) v[j] = w[j]; } }
    float* ssq = (float*)(ws + WS_SSQ);
    for (int i = (F.vcu * NWAVES * 64) + F.tid; i < 4 * M; i += F.G * NWAVES * 64) ssq[i] = 0.f;
}

struct GlaPre { v4u v[4]; v4u q[2]; v4u k[2]; v4u g; };
template <bool WANT_Q> __device__ __forceinline__ void gla_prefetch(GlaPre& P, const bf16* prow, const bf16* grow, int h, int tid) {
    const char* pb = (const char*)prow;
    const unsigned ov = (unsigned)(tid >> 5) * (N0P * 2) + (unsigned)(tid & 31) * 16, ok = (unsigned)(tid >> 4) * (N0P * 2) + (unsigned)(tid & 15) * 16, og = (unsigned)(tid & 127) * 16;
#pragma unroll
    for (int i = 0; i < 4; ++i) P.v[i] = *(const v4u*)(pb + ((size_t)(16 * i) * N0P + 1024 + h * 256) * 2 + ov);
#pragma unroll
    for (int i = 0; i < 2; ++i) { P.k[i] = *(const v4u*)(pb + ((size_t)(32 * i) * N0P + 512 + h * 128) * 2 + ok); if (WANT_Q) P.q[i] = *(const v4u*)(pb + ((size_t)(32 * i) * N0P + h * 128) * 2 + ok); }
    P.g = *(const v4u*)((const char*)grow + og);
}
constexpr int VSTR = 544, QSTR = 272, KDSTR = 144;
template <bool WANT_Q> __device__ __forceinline__ void gla_stage(const GlaPre& P, LAS unsigned char* Vs, LAS unsigned char* Ks, LAS unsigned char* Qs, LAS float* gl, int tid) {
#pragma unroll
    for (int i = 0; i < 4; ++i) { const int p = tid + 512 * i, t = p >> 5, ch = p & 31; *(LAS v4u*)(Vs + t * VSTR + ch * 16) = P.v[i]; }
#pragma unroll
    for (int i = 0; i < 2; ++i) { const int p = tid + 512 * i, t = p >> 4, ch = p & 15; *(LAS v4u*)(Ks + t * QSTR + ch * 16) = P.k[i]; if (WANT_Q) *(LAS v4u*)(Qs + t * QSTR + ch * 16) = P.q[i]; }
    if (tid < 128) *(LAS v4u*)((LAS unsigned char*)gl + tid * 16) = P.g;
}
#define MFMA16(a, b, c) __builtin_amdgcn_mfma_f32_16x16x32_bf16(a, b, c, 0, 0, 0)
__device__ __forceinline__ void gla_gate_mfma(const bf16x8 wuf, float bias, const LAS unsigned char* gl16, int l15, int g, float (&bl)[4][4], float& blast) {
    float carry = 0.f;
#pragma unroll
    for (int mt = 0; mt < 4; ++mt) {
        bf16x8 af = *(const LAS bf16x8*)(gl16 + (16 * mt + l15) * 32 + (g & 1) * 16); if (g >= 2) af = (bf16x8){0, 0, 0, 0, 0, 0, 0, 0};
        const f32x4 z = MFMA16(af, wuf, ((f32x4){bias, bias, bias, bias}));
        float p[4]; float run = 0.f;
#pragma unroll
        for (int r = 0; r < 4; ++r) { run += log_sigmoid(z[r]) * (1.0f / 16.0f); p[r] = run; }
        const float x1 = __shfl_up(run, 16), x2 = __shfl_up(run, 32), x3 = __shfl_up(run, 48);
        const float e = (g >= 1 ? x1 : 0.f) + (g >= 2 ? x2 : 0.f) + (g >= 3 ? x3 : 0.f);
        float tt = run + __shfl_xor(run, 16); tt += __shfl_xor(tt, 32);
#pragma unroll
        for (int r = 0; r < 4; ++r) bl[mt][r] = carry + e + p[r];
        carry += tt; }
    blast = carry;
}
__device__ __forceinline__ bf16x8 gla_wu_frag(const float* wup, int h, int w, int l15, int g) {
    const float* p = wup + (size_t)(8 * (g & 1)) * 512 + h * 128 + 16 * w + l15; float v[8];
#pragma unroll
    for (int j = 0; j < 8; ++j) v[j] = p[j * 512];
    v4u o; o.x = pk2(v[0], v[1]); o.y = pk2(v[2], v[3]); o.z = pk2(v[4], v[5]); o.w = pk2(v[6], v[7]);
    if (g >= 2) o = (v4u){0u, 0u, 0u, 0u};
    return __builtin_bit_cast(bf16x8, o);
}
__device__ __forceinline__ s16x4 tr16(const LAS unsigned char* p) { typedef short v4i16_t __attribute__((ext_vector_type(4))); return __builtin_bit_cast(s16x4, __builtin_amdgcn_ds_read_tr16_b64_v4i16((LAS v4i16_t*)p)); }
__device__ __forceinline__ void gla_pass_a(Frame& F, const Args& a) {
    const int tid = F.tid, lane = F.lane, w = F.wave, l15 = lane & 15, g = lane >> 4, c = tid & 127, tg = tid >> 7;
    LAS float* gl = (LAS float*)F.lds; LAS float* tot = (LAS float*)(F.lds + 4096); LAS unsigned char* Ks = F.lds + 8192; LAS unsigned char* KdT = F.lds + 25600; LAS unsigned char* Vs = F.lds + 45056;
    const bf16* proj = (const bf16*)(a.ws + WS_PROJ0); const bf16* glb = (const bf16*)(a.ws + WS_GLB);
    GlaPre P; int unit = F.vcu;
    if (unit < GUNITS) { const int bh = unit >> 7, n = unit & 127; gla_prefetch<false>(P, proj + ((size_t)(bh >> 2) * SEQ + (size_t)n * GC) * N0P, glb + ((size_t)(bh >> 2) * SEQ + (size_t)n * GC) * 16, bh & 3, tid); }
    for (; unit < GUNITS; unit += F.G) {
        const int bh = unit >> 7, h = bh & 3;
        gla_stage<false>(P, Vs, Ks, nullptr, gl, tid);
        const bf16x8 wuf = gla_wu_frag(a.in[3], h, w, l15, g); const float bias = a.in[4][h * 128 + 16 * w + l15];
        __syncthreads();
        { int nu = unit + F.G; if (nu >= GUNITS) nu = unit;        { const int nbh = nu >> 7, nn = nu & 127; gla_prefetch<false>(P, proj + ((size_t)(nbh >> 2) * SEQ + (size_t)nn * GC) * N0P, glb + ((size_t)(nbh >> 2) * SEQ + (size_t)nn * GC) * 16, nbh & 3, tid); } }
        float bl[4][4], blast;
        gla_gate_mfma(wuf, bias, (const LAS unsigned char*)gl, l15, g, bl, blast);
        { const int cc = 16 * w + l15;
#pragma unroll
          for (int mt = 0; mt < 4; ++mt) { float kd[4];
#pragma unroll
              for (int r = 0; r < 4; ++r) kd[r] = bf2f(*(const LAS bf16*)(Ks + (16 * mt + 4 * g + r) * QSTR + cc * 2)) * fexp(blast - bl[mt][r]);
              v2u o; o.x = pk2(kd[0], kd[1]); o.y = pk2(kd[2], kd[3]); *(LAS v2u*)(KdT + cc * KDSTR + (16 * mt + 4 * g) * 2) = o; }
          if (g == 0) ((float*)(a.ws + WS_DEC))[(size_t)unit * 128 + cc] = fexp(blast); }
        __syncthreads();
        f32x4 acc[2][8];
#pragma unroll
        for (int mt = 0; mt < 2; ++mt)
#pragma unroll
            for (int nt = 0; nt < 8; ++nt) acc[mt][nt] = (f32x4){0.f, 0.f, 0.f, 0.f};
#pragma unroll
        for (int s = 0; s < 2; ++s) { bf16x8 vf[2];
#pragma unroll
            for (int mt = 0; mt < 2; ++mt) { const LAS unsigned char* p = Vs + (32 * s + 4 * g + (l15 >> 2)) * VSTR + (32 * w + 16 * mt + 4 * (l15 & 3)) * 2;
                const s16x4 lo = tr16(p), hi = tr16(p + 16 * VSTR); vf[mt] = (bf16x8){lo[0], lo[1], lo[2], lo[3], hi[0], hi[1], hi[2], hi[3]}; }
#pragma unroll
            for (int nt = 0; nt < 8; ++nt) { const LAS unsigned char* p = KdT + (16 * nt + l15) * KDSTR + (32 * s + 4 * g) * 2;
                const s16x4 lo = *(const LAS s16x4*)p, hi = *(const LAS s16x4*)(p + 32); const bf16x8 kf = (bf16x8){lo[0], lo[1], lo[2], lo[3], hi[0], hi[1], hi[2], hi[3]};
#pragma unroll
                for (int mt = 0; mt < 2; ++mt) acc[mt][nt] = MFMA16(kf, vf[mt], acc[mt][nt]); } }
        bf16* S = (bf16*)a.out + (size_t)unit * 256 * 128;
#pragma unroll
        for (int mt = 0; mt < 2; ++mt)
#pragma unroll
            for (int nt = 0; nt < 8; ++nt) { v2u o; o.x = pk2(acc[mt][nt][0], acc[mt][nt][1]); o.y = pk2(acc[mt][nt][2], acc[mt][nt][3]);
                *(v2u*)((char*)S + (size_t)(32 * w + 16 * mt) * 256 + nt * 32 + (unsigned)(l15 * 256 + g * 8)) = o; }
        __syncthreads();
    }
}
__device__ __forceinline__ void gla_scan(Frame& F, const Args& a) {
    bf16* S = (bf16*)a.out; const float* dec = (const float*)(a.ws + WS_DEC);
    for (int id = F.vcu * 512 + F.tid; id < 16 * 256 * 32; id += F.G * 512) { const int c4 = id & 31, dv = (id >> 5) & 255, bh = id >> 13;
        float st[4] = {0.f, 0.f, 0.f, 0.f};
        v2u sl[16]; f32x4 d[16];
        { const char* pb = (const char*)(S + (((size_t)bh * GNC) * 256 + dv) * 128 + c4 * 4); const char* db = (const char*)(dec + ((size_t)bh * GNC) * 128 + c4 * 4);
#pragma unroll
          for (int j = 0; j < 16; ++j) { sl[j] = *(const v2u*)(pb + (size_t)j * 65536); d[j] = *(const f32x4*)(db + (size_t)j * 512); } }
#pragma unroll 1
        for (int n0 = 0; n0 < GNC; n0 += 16) {
            char* pb = (char*)(S + (((size_t)bh * GNC + n0) * 256 + dv) * 128 + c4 * 4);
            v2u sn[16]; f32x4 dn[16];
            if (n0 + 16 < GNC) { const char* pn = pb + (size_t)16 * 65536; const char* dnb = (const char*)(dec + ((size_t)bh * GNC + n0 + 16) * 128 + c4 * 4);
#pragma unroll
                for (int j = 0; j < 16; ++j) { sn[j] = *(const v2u*)(pn + (size_t)j * 65536); dn[j] = *(const f32x4*)(dnb + (size_t)j * 512); } }
#pragma unroll
            for (int j = 0; j < 16; ++j) { v2u o; o.x = pk2(st[0], st[1]); o.y = pk2(st[2], st[3]); *(v2u*)(pb + (size_t)j * 65536) = o;
                st[0] = st[0] * d[j][0] + bflo(sl[j].x); st[1] = st[1] * d[j][1] + bfhi(sl[j].x); st[2] = st[2] * d[j][2] + bflo(sl[j].y); st[3] = st[3] * d[j][3] + bfhi(sl[j].y); }
#pragma unroll
            for (int j = 0; j < 16; ++j) { sl[j] = sn[j]; d[j] = dn[j]; } } }
}
__device__ __forceinline__ void gla_pass_c(Frame& F, const Args& a) {
    const int tid = F.tid, lane = F.lane, w = F.wave, l15 = lane & 15, g = lane >> 4, c = tid & 127, tg = tid >> 7;
    LAS float* gl = (LAS float*)F.lds; LAS float* tot = (LAS float*)(F.lds + 4096); LAS float* ssqx = (LAS float*)(F.lds + 6144);
    LAS unsigned char* Qs = F.lds + 8192; LAS unsigned char* Ks = F.lds + 25600; LAS unsigned char* Vs = F.lds + 43008;
    const bf16* proj = (const bf16*)(a.ws + WS_PROJ0); const bf16* glb = (const bf16*)(a.ws + WS_GLB);
    const float qsc = 0.08838834764831845f;
    f32x4 gon[2];
#pragma unroll
    for (int nt = 0; nt < 2; ++nt) gon[nt] = *(const f32x4*)(a.in[5] + 32 * w + 16 * nt + 4 * g);
    GlaPre P; int unit = F.vcu;
    if (unit < GUNITS) { const int bh = unit >> 7, n = unit & 127; gla_prefetch<true>(P, proj + ((size_t)(bh >> 2) * SEQ + (size_t)n * GC) * N0P, glb + ((size_t)(bh >> 2) * SEQ + (size_t)n * GC) * 16, bh & 3, tid); }
    for (; unit < GUNITS; unit += F.G) {
        const int bh = unit >> 7, n = unit & 127, b = bh >> 2, h = bh & 3; const size_t row0 = (size_t)b * SEQ + (size_t)n * GC;
        const bf16* prow = proj + row0 * N0P;
        gla_stage<true>(P, Vs, Ks, Qs, gl, tid);
        const bf16x8 wuf = gla_wu_frag(a.in[3], h, w, l15, g); const float bias = a.in[4][h * 128 + 16 * w + l15];
        __syncthreads();
        { int nu = unit + F.G; if (nu >= GUNITS) nu = unit;        { const int nbh = nu >> 7, nn = nu & 127; gla_prefetch<true>(P, proj + ((size_t)(nbh >> 2) * SEQ + (size_t)nn * GC) * N0P, glb + ((size_t)(nbh >> 2) * SEQ + (size_t)nn * GC) * 16, nbh & 3, tid); } }
        float bl[4][4], blast;
        gla_gate_mfma(wuf, bias, (const LAS unsigned char*)gl, l15, g, bl, blast);
        const bf16* Sp = (const bf16*)a.out + (size_t)unit * 256 * 128;
        bf16x8 Sf[4][2]; v2u rv[4][2];
        { const char* sb = (const char*)Sp + (size_t)(32 * w) * 256; const unsigned so = (unsigned)l15 * 256 + (unsigned)g * 16;
#pragma unroll
          for (int kc = 0; kc < 4; ++kc)
#pragma unroll
              for (int nt = 0; nt < 2; ++nt) Sf[kc][nt] = *(const bf16x8*)(sb + nt * 4096 + kc * 64 + so);
          const char* rb = (const char*)prow + (size_t)(2048 + h * 256 + 32 * w) * 2; const unsigned ro = (unsigned)l15 * (N0P * 2) + (unsigned)g * 8;
#pragma unroll
          for (int it = 0; it < 4; ++it)
#pragma unroll
              for (int nt = 0; nt < 2; ++nt) rv[it][nt] = *(const v2u*)(rb + (size_t)(16 * it) * (N0P * 2) + nt * 32 + ro); }
        { const int cc = 16 * w + l15;
#pragma unroll
          for (int mt = 0; mt < 4; ++mt)
#pragma unroll
              for (int r = 0; r < 4; ++r) { const int t = 16 * mt + 4 * g + r; LAS bf16* qp = (LAS bf16*)(Qs + t * QSTR + cc * 2); LAS bf16* kp = (LAS bf16*)(Ks + t * QSTR + cc * 2);
                  *qp = (bf16)f2bf(bf2f(*qp) * qsc * fexp(bl[mt][r])); *kp = (bf16)f2bf(bf2f(*kp) * fexp(-bl[mt][r])); } }
        __syncthreads();
        v4u pf[4][2];
#pragma unroll
        for (int it = 0; it < 4; ++it) { pf[it][0] = (v4u){0u, 0u, 0u, 0u}; pf[it][1] = (v4u){0u, 0u, 0u, 0u}; }
#pragma unroll
        for (int it = 0; it < 4; ++it) { bf16x8 Qf[4];
#pragma unroll
            for (int kc = 0; kc < 4; ++kc) Qf[kc] = *(const LAS bf16x8*)(Qs + (16 * it + l15) * QSTR + (32 * kc + 8 * g) * 2);
#pragma unroll
            for (int jt = 0; jt <= it; ++jt) { f32x4 at = (f32x4){0.f, 0.f, 0.f, 0.f};
#pragma unroll
                for (int kc = 0; kc < 4; ++kc) { const bf16x8 Kf = *(const LAS bf16x8*)(Ks + (16 * jt + l15) * QSTR + (32 * kc + 8 * g) * 2); at = MFMA16(Kf, Qf[kc], at); }
                if (it == jt) {
#pragma unroll
                    for (int r = 0; r < 4; ++r) if (4 * g + r > l15) at[r] = 0.f; }
                const unsigned lo = pk2(at[0], at[1]), hi = pk2(at[2], at[3]);
                if (jt & 1) { pf[it][jt >> 1].z = lo; pf[it][jt >> 1].w = hi; } else { pf[it][jt >> 1].x = lo; pf[it][jt >> 1].y = hi; } }
            asm volatile("" ::: "memory"); }
        f32x4 acc[4][2];
#pragma unroll
        for (int it = 0; it < 4; ++it) { acc[it][0] = (f32x4){0.f, 0.f, 0.f, 0.f}; acc[it][1] = (f32x4){0.f, 0.f, 0.f, 0.f}; }
#pragma unroll
        for (int s = 0; s < 2; ++s)
#pragma unroll
            for (int nt = 0; nt < 2; ++nt) { const LAS unsigned char* p = Vs + (32 * s + 4 * g + (l15 >> 2)) * VSTR + (32 * w + 16 * nt + 4 * (l15 & 3)) * 2;
                const s16x4 lo = tr16(p), hi = tr16(p + 16 * VSTR); const bf16x8 vf = (bf16x8){lo[0], lo[1], lo[2], lo[3], hi[0], hi[1], hi[2], hi[3]};
#pragma unroll
                for (int it = 0; it < 4; ++it) acc[it][nt] = MFMA16(vf, __builtin_bit_cast(bf16x8, pf[it][s]), acc[it][nt]); }
#pragma unroll
        for (int it = 0; it < 4; ++it) { bf16x8 Qf[4];
#pragma unroll
            for (int kc = 0; kc < 4; ++kc) Qf[kc] = *(const LAS bf16x8*)(Qs + (16 * it + l15) * QSTR + (32 * kc + 8 * g) * 2);
#pragma unroll
            for (int kc = 0; kc < 4; ++kc)
#pragma unroll
                for (int nt = 0; nt < 2; ++nt) acc[it][nt] = MFMA16(Sf[kc][nt], Qf[kc], acc[it][nt]);
            asm volatile("" ::: "memory"); }
#pragma unroll
        for (int it = 0; it < 4; ++it) { float s = 0.f;
#pragma unroll
            for (int nt = 0; nt < 2; ++nt) s += (acc[it][nt][0] * acc[it][nt][0] + acc[it][nt][1] * acc[it][nt][1]) + (acc[it][nt][2] * acc[it][nt][2] + acc[it][nt][3] * acc[it][nt][3]);
            s += __shfl_xor(s, 16); s += __shfl_xor(s, 32);
            if (g == 0) ssqx[(16 * it + l15) * 8 + w] = s; }
        __syncthreads();
        char* yb = (char*)((bf16*)(a.ws + WS_Y0) + row0 * 1024 + h * 256 + 32 * w); const unsigned yo = (unsigned)l15 * 2048 + (unsigned)g * 8;
#pragma unroll
        for (int it = 0; it < 4; ++it) { const LAS f32x4* sp = (const LAS f32x4*)(ssqx + (16 * it + l15) * 8); const f32x4 s0 = sp[0], s1 = sp[1];
            const float rstd = frsq(((s0[0] + s0[1]) + (s0[2] + s0[3]) + (s1[0] + s1[1]) + (s1[2] + s1[3])) * (1.0f / 256.0f) + EPS);
#pragma unroll
            for (int nt = 0; nt < 2; ++nt) { const float r0 = bflo(rv[it][nt].x), r1 = bfhi(rv[it][nt].x), r2 = bflo(rv[it][nt].y), r3 = bfhi(rv[it][nt].y);
                const f32x4 o = acc[it][nt] * rstd * gon[nt];
                v2u y; y.x = pk2(o[0] * (r0 * frcp(1.0f + fexp(-r0))), o[1] * (r1 * frcp(1.0f + fexp(-r1)))); y.y = pk2(o[2] * (r2 * frcp(1.0f + fexp(-r2))), o[3] * (r3 * frcp(1.0f + fexp(-r3))));
                *(v2u*)(yb + (size_t)(16 * it) * 2048 + nt * 32 + yo) = y; } }
        __syncthreads();
    }
}

template <int MODE  >
__device__ __forceinline__ void thin_gemm16(Frame& F, const bf16* A, const bf16* Wt, const float* rs, const float* bfg, void* out) {
    const int l15 = F.lane & 15, g = F.lane >> 4;
    for (int blk = F.vcu * NWAVES + F.wave; blk < M / 16; blk += F.G * NWAVES) {
        const char* ab = (const char*)(A + (size_t)blk * 16 * D); const unsigned ao = (unsigned)l15 * (D * 2) + (unsigned)g * 16;
        const char* wb = (const char*)Wt;
        f32x4 acc = (f32x4){0.f, 0.f, 0.f, 0.f};
#pragma unroll
        for (int kb = 0; kb < 2; ++kb) { bf16x8 af[16], wf[16];
#pragma unroll
            for (int s = 0; s < 16; ++s) { af[s] = *(const bf16x8*)(ab + (kb * 16 + s) * 64 + ao); wf[s] = *(const bf16x8*)(wb + (kb * 16 + s) * 64 + ao); }
#pragma unroll
            for (int s = 0; s < 16; ++s) acc = MFMA16(af[s], wf[s], acc);
            asm volatile("" ::: "memory"); }
        float rv[4];
#pragma unroll
        for (int r = 0; r < 4; ++r) rv[r] = rs[blk * 16 + 4 * g + r];
        const float bb = MODE == 1 ? bfg[l15] : 0.f;
#pragma unroll
        for (int r = 0; r < 4; ++r) { const int row = blk * 16 + 4 * g + r;
            if (MODE == 0) { ((bf16*)out)[(size_t)row * 16 + l15] = (bf16)f2bf(acc[r] * rv[r]); }
            else { const float z = acc[r] * (frsq(rv[r] * (1.0f / D) + EPS)) + bb; ((float*)out)[(size_t)row * 16 + l15] = log_sigmoid(z) * LOG2E; } }
    }
}
__device__ __forceinline__ void fox_cumsum(Frame& F, const Args& a) {
    const float* LF = (const float*)(a.ws + WS_LF); float* CB = (float*)(a.ws + WS_CB); LAS double* wt = (LAS double*)F.lds;
    for (int item = F.vcu; item < BATCH * 16 * 4; item += F.G) { const int bh = item >> 2, q = item & 3, b = bh >> 4, h = bh & 15;
        const float* src = LF + (size_t)b * SEQ * 16 + h;
        double carry = 0.0;
        { float cv[12];
#pragma unroll
          for (int j = 0; j < 12; ++j) { const int p = F.tid + 512 * j; cv[j] = src[(size_t)(p < 2048 * q ? p : 0) * 16]; }
#pragma unroll
          for (int j = 0; j < 12; ++j) carry += (F.tid + 512 * j < 2048 * q) ? (double)cv[j] : 0.0; }
#pragma unroll
        for (int o = 1; o < 64; o <<= 1) carry += __shfl_xor(carry, o);
        double loc[4]; double run = 0.0; const int p0 = 2048 * q + 4 * F.tid;
#pragma unroll
        for (int e = 0; e < 4; ++e) { run += (double)src[(size_t)(p0 + e) * 16]; loc[e] = run; }
        double inc = run;
#pragma unroll
        for (int o = 1; o < 64; o <<= 1) { const double v = __shfl_up(inc, o); if (F.lane >= o) inc += v; }
        if (F.lane == 63) { wt[F.wave] = inc; wt[8 + F.wave] = carry; }
        __syncthreads();
        double off = inc - run;
        for (int w = 0; w < NWAVES; ++w) { off += wt[8 + w]; if (w < F.wave) off += wt[w]; }
#pragma unroll
        for (int e = 0; e < 4; ++e) CB[(size_t)bh * SEQ + p0 + e] = (float)(off + loc[e]);
        __syncthreads();
    }
}
__device__ __forceinline__ void final_norm(Frame& F, const Args& a) {
    const int gw = F.vcu * NWAVES + F.wave, NGW = F.G * NWAVES; const float* ssq = (const float*)(a.ws + WS_SSQ) + 3 * M; const float* gf = a.in[19]; const bf16* XB = (const bf16*)(a.ws + WS_XB);
    f32x4 gv[4];
#pragma unroll
    for (int j = 0; j < 4; ++j) gv[j] = ((const f32x4*)gf)[F.lane + 64 * j];
    int m = 2 * gw; v2u v[8]; float q0 = 0.f, q1 = 0.f;
    if (m < M) { const v2u* xr = (const v2u*)(XB + (size_t)m * D) + F.lane;
#pragma unroll
        for (int j = 0; j < 8; ++j) v[j] = xr[64 * j];
        q0 = ssq[m]; q1 = ssq[m + 1]; }
#pragma unroll 1
    for (; m < M; m += 2 * NGW) { const int mn = m + 2 * NGW; v2u w[8]; float n0 = 0.f, n1 = 0.f;
        if (mn < M) { const v2u* xn = (const v2u*)(XB + (size_t)mn * D) + F.lane;
#pragma unroll
            for (int j = 0; j < 8; ++j) w[j] = xn[64 * j];
            n0 = ssq[mn]; n1 = ssq[mn + 1]; }
        const float rs0 = frsq(q0 * (1.0f / D) + EPS), rs1 = frsq(q1 * (1.0f / D) + EPS);
        f32x4* xo = (f32x4*)(a.out + (size_t)m * D) + F.lane;
#pragma unroll
        for (int j = 0; j < 8; ++j) { const f32x4 x = (f32x4){bflo(v[j].x), bfhi(v[j].x), bflo(v[j].y), bfhi(v[j].y)}; xo[64 * j] = x * (j < 4 ? rs0 : rs1) * gv[j & 3]; }
#pragma unroll
        for (int j = 0; j < 8; ++j) v[j] = w[j];
        q0 = n0; q1 = n1; }
}

typedef __attribute__((address_space(1))) unsigned gu32;
#define RLX_AGENT __ATOMIC_RELAXED, __HIP_MEMORY_SCOPE_AGENT
#define XB_TMO      128
#define XB_XCNT(j)  (256  + 64 * (j))
#define XB_XSUB(j)  (1280 + 64 * (j))
#define XB_XGEN(j)  (2304 + 64 * (j))
#define XB_TOP      3328
#define XB_TOPGEN   3392
#define XCD_BAR_WORDS 3456
#define XB_SPIN_CAP (1u << 18)

__device__ __forceinline__ unsigned xb_ld(unsigned* p)              { return __hip_atomic_load(p, __ATOMIC_RELAXED, __HIP_MEMORY_SCOPE_AGENT); }
__device__ __forceinline__ unsigned xb_add(unsigned* p, unsigned v) { return __hip_atomic_fetch_add(p, v, __ATOMIC_RELAXED, __HIP_MEMORY_SCOPE_AGENT); }
__device__ __forceinline__ unsigned xb_xcc_id() { return (unsigned)__builtin_amdgcn_s_getreg((3 << 11) | 20) & 0xFu; }
#define XB_SPIN(cond, bar) do { unsigned _sp = 0; while (cond) { __builtin_amdgcn_s_sleep(1); \
    if ((++_sp & 255u) == 0u) { if (xb_ld(&(bar)[XB_TMO])) break; if (_sp > XB_SPIN_CAP) { atomicAdd(&(bar)[XB_TMO], 1u); break; } } } } while (0)

struct XcdBarrier {
    unsigned* bar; unsigned x;
    volatile LAS unsigned* st;
};

__device__ __forceinline__ XcdBarrier xcd_barrier_post(unsigned* bar, volatile LAS unsigned* st) {
    XcdBarrier b; b.bar = bar; b.x = xb_xcc_id(); b.st = st;
    if (mk_tid() == 0) (void)xb_add(&bar[XB_XCNT(b.x)], 1u);
    return b;
}
__device__ __forceinline__ void xcd_barrier_complete(unsigned* bar, unsigned x, unsigned& nloc, unsigned& nx) {
    const unsigned G = gridDim.x * gridDim.y * gridDim.z;
    unsigned sum, cnt, mine, sp = 0u;
    for (;;) {
        sum = 0u; cnt = 0u; mine = 0u;
#pragma unroll
        for (unsigned j = 0; j < 16; ++j) { const unsigned c = xb_ld(&bar[XB_XCNT(j)]); sum += c; cnt += (c > 0u) ? 1u : 0u; mine = (j == x) ? c : mine; }
        if (sum == G) break;
        __builtin_amdgcn_s_sleep(1);
        if ((++sp & 255u) == 0u) { if (xb_ld(&bar[XB_TMO])) break; if (sp > XB_SPIN_CAP) { atomicAdd(&bar[XB_TMO], 1u); break; } }
    }
    nloc = mine > 0u ? mine : 1u; nx = cnt > 0u ? cnt : 1u;
}

__device__ __forceinline__ void xcd_barrier(const XcdBarrier& b) {
    asm volatile("s_waitcnt vmcnt(0)" ::: "memory");
    __syncthreads();
    if (mk_tid() == 0) {
        unsigned* bar = b.bar;
        __builtin_amdgcn_s_waitcnt(0);
        unsigned nloc = b.st[0], nx = b.st[1];
        if (nloc == 0u) { xcd_barrier_complete(bar, b.x, nloc, nx); b.st[0] = nloc; b.st[1] = nx; }
        const unsigned old = xb_add(&bar[XB_XSUB(b.x)], 1u);
        const unsigned gen = old / nloc;
        if (old + 1u == (gen + 1u) * nloc) {
            __builtin_amdgcn_fence(__ATOMIC_RELEASE, "agent");
            asm volatile("s_waitcnt vmcnt(0)" ::: "memory");
            const unsigned og = xb_add(&bar[XB_TOP], 1u);
            const unsigned tg = og / nx;
            if (og + 1u == (tg + 1u) * nx) xb_add(&bar[XB_TOPGEN], 1u);
            else XB_SPIN(xb_ld(&bar[XB_TOPGEN]) == tg, bar);
            __builtin_amdgcn_fence(__ATOMIC_ACQUIRE, "agent");
            xb_add(&bar[XB_XGEN(b.x)], 1u);
            asm volatile("s_waitcnt vmcnt(0)" ::: "memory");
        } else {
            XB_SPIN(xb_ld(&bar[XB_XGEN(b.x)]) == gen, bar);
            __builtin_amdgcn_fence(__ATOMIC_ACQUIRE, "agent");
            asm volatile("s_waitcnt vmcnt(0)" ::: "memory");
        }
    }
    __syncthreads();
}

constexpr int MISC_OFF = RING_BYTES + 320;
constexpr size_t WS_BAR = 65536;
#ifndef MK_MULTI
#define MK_MULTI 0
#endif
constexpr int N_PHASES = 15;
__device__ __forceinline__ Args load_args() {
    const __attribute__((address_space(4))) Args* p = (const __attribute__((address_space(4))) Args*)__builtin_amdgcn_kernarg_segment_ptr(); asm volatile("" : "+s"(p)); const Args* g = (const Args*)p; return *g; }
__global__ void __launch_bounds__(NWAVES * 64, 2) mk_fwd(Args args_) {
    extern __shared__ __attribute__((aligned(16))) unsigned char lds[];
    Frame F; F.lds = (LAS unsigned char*)lds;
    { const int t0_ = threadIdx.x; const unsigned hw = __builtin_amdgcn_s_getreg(4 | ((6 - 1) << 11)) & 63u; if ((t0_ & 63) == 0) ((LAS int*)(F.lds + RING_BYTES))[hw] = t0_ >> 6; }
    __syncthreads();
    F.tid = mk_tid(); F.lane = F.tid & 63; F.wave = __builtin_amdgcn_readfirstlane(F.tid >> 6);
    F.G = gridDim.x; { const int bx = blockIdx.x; F.vcu = (F.G % 8 == 0) ? (bx % 8) * (F.G / 8) + bx / 8 : bx; }
    const int lo = MK_MULTI ? args_.ph_lo : 0, hi = MK_MULTI ? args_.ph_hi : N_PHASES;
    if (F.tid < 32) ((LAS unsigned*)(F.lds + MISC_OFF))[F.tid] = 0u;
    __syncthreads();
    XcdBarrier bar; bar.bar = nullptr; bar.x = 0; bar.st = nullptr;
    if (!MK_MULTI) bar = xcd_barrier_post((unsigned*)(args_.ws + WS_BAR), (volatile LAS unsigned*)(F.lds + MISC_OFF) + 8);
    if (args_.ph_hi == 0x7fffffff) cg::this_grid().sync();
#ifndef PH_MASK
#define PH_MASK 0x7fff
#endif
#define IN(k) (((PH_MASK >> (k)) & 1) && lo <= (k) && (k) < hi)
#define SEAM(k) do { if (IN(k) && IN((k) + 1)) { xcd_barrier(bar); } { int t_ = mk_tid(); asm volatile("" : "+v"(t_)); F.tid = t_; F.lane = t_ & 63; F.wave = __builtin_amdgcn_readfirstlane(t_ >> 6); } } while (0)
#define PH_ARGS() const Args args = load_args(); unsigned char* ws = args.ws; bf16* XB = (bf16*)(ws + WS_XB); float* ssq = (float*)(ws + WS_SSQ); (void)XB; (void)ssq
    if (IN(0)) { PH_ARGS(); if (MK_MULTI && blockIdx.x == 0) { unsigned* bw = (unsigned*)(ws + WS_BAR); for (int i = F.tid; i < 4096 + 64; i += NWAVES * 64) bw[i] = 0u; } p0_prologue(F, args); } SEAM(0);
    if (IN(1)) { PH_ARGS(); thin_gemm16<0>(F, XB, (const bf16*)(ws + WS_WG0), (const float*)(ws + WS_RSTD0), nullptr, ws + WS_GLB); __syncthreads();
        pg8::Gemm g{XB, (const bf16*)(ws + WS_WIN0), M, N0P, D}; pg8::StaticOrder S; S.init(M, N0P, F.G, (int)blockIdx.x);
        pg8::EpiScaleBf16<0, 0> E{(bf16*)(ws + WS_PROJ0), N0P, (const float*)(ws + WS_RSTD0)};
        pg8::gemm_phase<pg8::EpiScaleBf16<0, 0>, pg8::StaticOrder, true, true>(F.lds, g, S, E); } SEAM(1);
    if (IN(2)) { PH_ARGS(); gla_pass_a(F, args); } SEAM(2);
    if (IN(3)) { PH_ARGS(); gla_scan(F, args); } SEAM(3);
    if (IN(4)) { PH_ARGS(); gla_pass_c(F, args); } SEAM(4);
    if (IN(5)) { PH_ARGS(); pg8::Gemm g{(const bf16*)(ws + WS_Y0), (const bf16*)(ws + WS_WOUT0), M, D, D}; pg8::StaticOrder S; S.init(M, D, F.G, (int)blockIdx.x);
        typedef pg8::EpiRes<true, false, true> ER; ER E{nullptr, XB, nullptr, XB, ssq};
        pg8::gemm_phase<ER, pg8::StaticOrder, true, true>(F.lds, g, S, E); } SEAM(5);
    if (IN(6)) { PH_ARGS(); pg8::Gemm g{XB, (const bf16*)(ws + WS_W1A), M, FF, D}; pg8::StaticOrder S; S.init(M, FF, F.G, (int)blockIdx.x);
        pg8::EpiScaleBf16<1, 1> E{(bf16*)(ws + WS_U), FF, ssq};
        pg8::gemm_phase<pg8::EpiScaleBf16<1, 1>, pg8::StaticOrder, true, true>(F.lds, g, S, E); } SEAM(6);
    if (IN(7)) { PH_ARGS(); pg8::Gemm g{(const bf16*)(ws + WS_U), (const bf16*)(ws + WS_W2A), M, D, FF}; pg8::StaticOrder S; S.init(M, D, F.G, (int)blockIdx.x);
        typedef pg8::EpiRes<true, false, true> ER; ER E{nullptr, XB, nullptr, XB, ssq + M};
        pg8::gemm_phase<ER, pg8::StaticOrder, true, true>(F.lds, g, S, E); } SEAM(7);
    if (IN(8)) { PH_ARGS(); thin_gemm16<1>(F, XB, (const bf16*)(ws + WS_WF1), ssq + M, args.in[12], ws + WS_LF); __syncthreads();
        pg8::Gemm g{XB, (const bf16*)(ws + WS_WIN1), M, N1P, D}; pg8::StaticOrder S; S.init(M, N1P, F.G, (int)blockIdx.x);
        pg8::EpiFox E{(bf16*)(ws + WS_Q), (bf16*)(ws + WS_K), (bf16*)(ws + WS_V), (bf16*)(ws + WS_G), (float*)(ws + WS_LF), ssq + M, args.in[13], args.in[14], args.in[12], attn_body::C2, (unsigned*)(ws + WS_BAR) + 4096 + 128};
        pg8::gemm_phase<pg8::EpiFox, pg8::StaticOrder, true, true>(F.lds, g, S, E); } SEAM(8);
    if (IN(9)) { PH_ARGS(); fox_cumsum(F, args); } SEAM(9);
    if (IN(10)) { PH_ARGS(); const attn_body::AttnTensors AT{(const attn_body::bf16*)(ws + WS_Q), (const attn_body::bf16*)(ws + WS_K), (const attn_body::bf16*)(ws + WS_V), (const attn_body::bf16*)(ws + WS_G),
                                               (const float*)(ws + WS_CB), args.in[13], args.in[14], (attn_body::bf16*)(ws + WS_O), (unsigned*)(ws + WS_BAR) + 4096, (const unsigned*)(ws + WS_BAR) + 4096 + 128};
        const attn_body::StaticOrder S((int)F.G, (int)blockIdx.x);
        attn_body::attn_phase<attn_body::StaticOrder>((char*)lds, AT, S); } SEAM(10);
    if (IN(11)) { PH_ARGS(); pg8::Gemm g{(const bf16*)(ws + WS_O), (const bf16*)(ws + WS_WOUT1), M, D, D}; pg8::StaticOrder S; S.init(M, D, F.G, (int)blockIdx.x);
        typedef pg8::EpiRes<true, false, true> ER; ER E{nullptr, XB, nullptr, XB, ssq + 2 * M};
        pg8::gemm_phase<ER, pg8::StaticOrder, true, true>(F.lds, g, S, E); } SEAM(11);
    if (IN(12)) { PH_ARGS(); pg8::Gemm g{XB, (const bf16*)(ws + WS_W1B), M, FF, D}; pg8::StaticOrder S; S.init(M, FF, F.G, (int)blockIdx.x);
        pg8::EpiScaleBf16<1, 1> E{(bf16*)(ws + WS_U), FF, ssq + 2 * M};
        pg8::gemm_phase<pg8::EpiScaleBf16<1, 1>, pg8::StaticOrder, true, true>(F.lds, g, S, E); } SEAM(12);
    if (IN(13)) { PH_ARGS(); pg8::Gemm g{(const bf16*)(ws + WS_U), (const bf16*)(ws + WS_W2B), M, D, FF}; pg8::StaticOrder S; S.init(M, D, F.G, (int)blockIdx.x);
        typedef pg8::EpiRes<true, false, true> ER; ER E{nullptr, XB, nullptr, XB, ssq + 3 * M};
        pg8::gemm_phase<ER, pg8::StaticOrder, true, true>(F.lds, g, S, E); } SEAM(13);
    if (IN(14)) { PH_ARGS(); final_norm(F, args); }
#undef IN
#undef SEAM
}

extern "C" void kernel_launch(void* const* d_in, const int* in_sizes, int n_in, void* d_out, int out_size, void* d_ws, size_t ws_size, hipStream_t stream) {
    static int grid = 0;
    if (grid == 0) {
        if (n_in != 20 || in_sizes[0] != M * D || out_size != M * D || ws_size < WS_END) { fprintf(stderr, "kernel_launch: unexpected shapes (n_in %d, in0 %d, out %d, ws %zu); nothing launched\n", n_in, n_in > 0 ? in_sizes[0] : -1, out_size, ws_size); grid = -1; return; }
        int dev = 0, cus = 0, per_cu = 0;
        if (hipGetDevice(&dev) != hipSuccess || hipDeviceGetAttribute(&cus, hipDeviceAttributeMultiprocessorCount, dev) != hipSuccess) { grid = -1; return; }
        if (hipFuncSetAttribute((const void*)mk_fwd, hipFuncAttributeMaxDynamicSharedMemorySize, LDS_BYTES) != hipSuccess) { fprintf(stderr, "kernel_launch: hipFuncSetAttribute failed\n"); grid = -1; return; }
        if (hipOccupancyMaxActiveBlocksPerMultiprocessor(&per_cu, (const void*)mk_fwd, NWAVES * 64, LDS_BYTES) != hipSuccess || per_cu < 1) { fprintf(stderr, "kernel_launch: occupancy query says %d blocks per CU\n", per_cu); per_cu = 1; }
        (void)hipGetLastError();
        grid = cus;
        if (grid != 256) fprintf(stderr, "kernel_launch: note: %d CUs (the attention order is balanced for 256)\n", grid);
    }
    if (grid < 0) return;
    Args a{};
    for (int i = 0; i < 20; ++i) a.in[i] = (const float*)d_in[i];
    a.out = (float*)d_out; a.ws = (unsigned char*)d_ws;
#if MK_MULTI
    for (int p = 0; p < N_PHASES; ++p) { a.ph_lo = p; a.ph_hi = p + 1; hipLaunchKernelGGL(mk_fwd, dim3(grid), dim3(NWAVES * 64), LDS_BYTES, stream, a); }
#else
    a.ph_lo = 0; a.ph_hi = N_PHASES;
    if (hipMemsetAsync((char*)d_ws + WS_BAR, 0, (4096 + 64) * 4, stream) != hipSuccess) { fprintf(stderr, "kernel_launch: hipMemsetAsync of the barrier / queue words failed; nothing launched\n"); return; }
    void* kargs[] = {&a};
    const hipError_t e = hipLaunchCooperativeKernel((const void*)mk_fwd, dim3(grid), dim3(NWAVES * 64), kargs, LDS_BYTES, stream);
    if (e != hipSuccess) fprintf(stderr, "kernel_launch: cooperative launch failed: %s (grid %d)\n", hipGetErrorString(e), grid);
#endif
}
```

```cpp
#include <hip/hip_runtime.h>
#include <hip/hip_cooperative_groups.h>
#include <hip/hip_bf16.h>
#include <cstdio>
#include <cstdint>
#include <cmath>
namespace cg = cooperative_groups;
__device__ __forceinline__ int mk_tid() {
    const unsigned hw = __builtin_amdgcn_s_getreg(4 | ((6 - 1) << 11)) & 63u;
    const int wave = *(const volatile __attribute__((address_space(3))) int*)(unsigned)(131072u + 4u * hw);
    int lane; asm volatile("v_mbcnt_lo_u32_b32 %0, -1, 0\n\tv_mbcnt_hi_u32_b32 %0, -1, %0" : "=v"(lane));
    return __builtin_amdgcn_readfirstlane(wave) * 64 + lane;
}
namespace pg8 {
#define PG8_LAS __attribute__((address_space(3)))
typedef unsigned short bf16_t;
typedef short bf16x8 __attribute__((ext_vector_type(8)));
typedef float f32x4 __attribute__((ext_vector_type(4)));
typedef unsigned u32x4 __attribute__((ext_vector_type(4)));
constexpr int BM = 256, BK = 64, HALF = 128, HTB = HALF * BK * 2  , STAGE_BYTES = 8 * HTB, NXCD = 8, WGM = 8;

__host__ __device__ __forceinline__ int lds_byte(int r, int c) { const int st = (r >> 4) * 2 + (c >> 5), rr = r & 15, cc = c & 31, ob = rr * 64 + cc * 2; return st * 1024 + (ob ^ (((ob >> 9) & 1) << 5)); }
__host__ __device__ __forceinline__ void stage_rc(int b, int& R, int& C) { const int st = b / 1024, sb = b % 1024, swz = sb ^ (((sb >> 9) & 1) << 5); R = (st >> 1) * 16 + swz / 64; C = (st & 1) * 32 + (swz % 64) / 2; }
__host__ __device__ __forceinline__ int perm32(int rho) { const int n = rho >> 4, i = rho & 15; return 8 * (i >> 2) + 4 * n + (i & 3); }

struct Unit { int pm, pn; };
struct Gemm { const bf16_t* A; const bf16_t* Bt; int M, N, K; };

struct StaticOrder {
    int nM, nN, nwg, G, c;
    __host__ __device__ void init(int M, int N, int G_, int c_) { nM = M / BM; nN = N / BM; nwg = nM * nN; G = G_; c = c_; }
    __host__ __device__ bool next(int i, Unit& u) const {
        const long L = (long)i * G + c; if (L >= nwg) return false;
        int wgid = (int)L; { const int q = nwg / NXCD, r = nwg % NXCD, xcd = wgid % NXCD, off = wgid / NXCD; wgid = (xcd < r ? xcd * (q + 1) : r * (q + 1) + (xcd - r) * q) + off; }
        const int nig = WGM * nN, gid = wgid / nig, fm = gid * WGM, gsz = (nM - fm) < WGM ? (nM - fm) : WGM;
        u.pm = fm + ((wgid % nig) % gsz); u.pn = (wgid % nig) / gsz; return true;
    }
    __device__ __forceinline__ void a_ready(const Unit&) const {}
    __device__ __forceinline__ void done(const Unit&) const {}
};

__device__ __forceinline__ unsigned cvt_pk_bf16(float lo, float hi) { unsigned r; asm volatile("v_cvt_pk_bf16_f32 %0, %1, %2" : "=v"(r) : "v"(lo), "v"(hi)); return r; }
constexpr float EPS_ = 1e-6f;
template <int ACT  , int RSMODE  > struct EpiScaleBf16 {
    static constexpr bool PERM = true, AFTER_DRAIN = false;
    bf16_t* O; int ldc; const float* rs;
    __device__ __forceinline__ void pre(const Unit& u, int wr, int fr, float (&p)[8]) const { const int row0 = u.pm * BM + wr * 64 + fr;
#pragma unroll
        for (int i = 0; i < 8; ++i) p[i] = rs[row0 + (i >> 2) * HALF + (i & 3) * 16]; }
    __device__ __forceinline__ void operator()(const f32x4 (&acc)[2][2][4][2], const Unit& u, int wr, int wc, int fr, int fq, const float (&p)[8]) const {
        const int row0 = u.pm * BM + wr * 64 + fr, col0 = u.pn * BM + wc * 64 + 8 * fq;
        float sv[2][4];
#pragma unroll
        for (int i = 0; i < 8; ++i) sv[i >> 2][i & 3] = p[i];
#pragma unroll
        for (int ai = 0; ai < 2; ++ai)
#pragma unroll
            for (int m = 0; m < 4; ++m) { const int row = row0 + ai * HALF + m * 16; float s = sv[ai][m]; if (RSMODE == 1) s = __builtin_amdgcn_rsqf(s * (1.0f / 1024.0f) + EPS_);
                bf16_t* rowp = O + (size_t)row * ldc + col0;
#pragma unroll
                for (int bj = 0; bj < 2; ++bj) { f32x4 v0 = acc[ai][bj][m][0] * s, v1 = acc[ai][bj][m][1] * s;
                    if (ACT == 1) {
#pragma unroll
                        for (int i = 0; i < 4; ++i) { const float a = fmaxf(v0[i], 0.f), b = fmaxf(v1[i], 0.f); v0[i] = a * a; v1[i] = b * b; } }
                    u32x4 w; w.x = cvt_pk_bf16(v0[0], v0[1]); w.y = cvt_pk_bf16(v0[2], v0[3]); w.z = cvt_pk_bf16(v1[0], v1[1]); w.w = cvt_pk_bf16(v1[2], v1[3]);
                    *(u32x4*)(rowp + bj * 32) = w; } }
    }
};
template <bool BASE_BF16, bool OUT_F32, bool OUT_BF16> struct EpiRes {
    static constexpr bool PERM = false, AFTER_DRAIN = false;
    const float* base32; const bf16_t* base16; float* out; bf16_t* ob; float* ssq;
    __device__ __forceinline__ void pre(const Unit&, int, int, float (&p)[8]) const {
#pragma unroll
        for (int i = 0; i < 8; ++i) p[i] = 0.f; }
    __device__ __forceinline__ void operator()(const f32x4 (&acc)[2][2][4][2], const Unit& u, int wr, int wc, int fr, int fq, const float (&)[8]) const {
        typedef unsigned u32x2v __attribute__((ext_vector_type(2)));
        const int row0 = u.pm * BM + wr * 64 + fr, col0 = u.pn * BM + wc * 64 + 4 * fq;
#pragma unroll
        for (int ai = 0; ai < 2; ++ai) {
            f32x4 bv[4][2][2];
#pragma unroll
            for (int m = 0; m < 4; ++m)
#pragma unroll
                for (int bj = 0; bj < 2; ++bj)
#pragma unroll
                    for (int n = 0; n < 2; ++n) { const size_t o = (size_t)(row0 + ai * HALF + m * 16) * 1024 + col0 + bj * 32 + n * 16;
                        if (BASE_BF16) { const u32x2v w = *(const u32x2v*)(base16 + o); bv[m][bj][n] = (f32x4){__uint_as_float(w.x << 16), __uint_as_float(w.x & 0xffff0000u), __uint_as_float(w.y << 16), __uint_as_float(w.y & 0xffff0000u)}; }
                        else bv[m][bj][n] = *(const f32x4*)(base32 + o); }
#pragma unroll
            for (int m = 0; m < 4; ++m) { const int row = row0 + ai * HALF + m * 16; const size_t off = (size_t)row * 1024 + col0; float s = 0.f;
#pragma unroll
                for (int bj = 0; bj < 2; ++bj)
#pragma unroll
                    for (int n = 0; n < 2; ++n) { const size_t o = off + bj * 32 + n * 16; const f32x4 v = acc[ai][bj][m][n] + bv[m][bj][n];
                        if (OUT_F32) *(f32x4*)(out + o) = v;
                        s += (v[0] * v[0] + v[1] * v[1]) + (v[2] * v[2] + v[3] * v[3]);
                        if (OUT_BF16) { u32x2v w; w.x = cvt_pk_bf16(v[0], v[1]); w.y = cvt_pk_bf16(v[2], v[3]); *(u32x2v*)(ob + o) = w; } }
                s += __shfl_xor(s, 16); s += __shfl_xor(s, 32);
                if (fq == 0) atomicAdd(ssq + row, s); }
            asm volatile("" ::: "memory"); }
    }
};
struct EpiFox {
    static constexpr bool PERM = true, AFTER_DRAIN = false;
    bf16_t* Q; bf16_t* K; bf16_t* V; bf16_t* G; float* LF; const float* ssq; const float* gq; const float* gk; const float* bfg; float qscale; unsigned* nrm;
    __device__ __forceinline__ void pre(const Unit& u, int wr, int fr, float (&p)[8]) const { const int row0 = u.pm * BM + wr * 64 + fr;
#pragma unroll
        for (int i = 0; i < 8; ++i) p[i] = ssq[row0 + (i >> 2) * HALF + (i & 3) * 16]; }
    __device__ __forceinline__ void operator()(const f32x4 (&acc)[2][2][4][2], const Unit& u, int wr, int wc, int fr, int fq, const float (&p)[8]) const {
        const int kind = u.pn >> 2; const int row0 = u.pm * BM + wr * 64 + fr, col0 = (u.pn & 3) * BM + wc * 64 + 8 * fq;
        f32x4 gv[2][2]; const float* gsel = kind == 0 ? gq : gk; const float gsc = kind == 0 ? qscale : 1.0f;
#pragma unroll
        for (int bj = 0; bj < 2; ++bj)
#pragma unroll
            for (int n = 0; n < 2; ++n) gv[bj][n] = *(const f32x4*)(gsel + bj * 32 + 8 * fq + 4 * n) * gsc;
        bf16_t* dst = kind == 0 ? Q : kind == 1 ? K : kind == 2 ? V : G;
        float sq[2][4]; float nmax = 0.f;
#pragma unroll
        for (int i = 0; i < 8; ++i) sq[i >> 2][i & 3] = p[i];
#pragma unroll
        for (int ai = 0; ai < 2; ++ai)
#pragma unroll
            for (int m = 0; m < 4; ++m) { const int row = row0 + ai * HALF + m * 16; const float rs = __builtin_amdgcn_rsqf(sq[ai][m] * (1.0f / 1024.0f) + EPS_);
                f32x4 v[2][2];
#pragma unroll
                for (int bj = 0; bj < 2; ++bj)
#pragma unroll
                    for (int n = 0; n < 2; ++n) v[bj][n] = acc[ai][bj][m][n] * rs;
                if (kind < 2) { float s = 0.f;
#pragma unroll
                    for (int bj = 0; bj < 2; ++bj)
#pragma unroll
                        for (int n = 0; n < 2; ++n) s += (v[bj][n][0] * v[bj][n][0] + v[bj][n][1] * v[bj][n][1]) + (v[bj][n][2] * v[bj][n][2] + v[bj][n][3] * v[bj][n][3]);
                    s += __shfl_xor(s, 16); s += __shfl_xor(s, 32);
                    const float hn = __builtin_amdgcn_rsqf(s * (1.0f / 64.0f) + EPS_);
#pragma unroll
                    for (int bj = 0; bj < 2; ++bj)
#pragma unroll
                        for (int n = 0; n < 2; ++n) v[bj][n] = v[bj][n] * hn * gv[bj][n];
                    float n2 = 0.f;
#pragma unroll
                    for (int bj = 0; bj < 2; ++bj)
#pragma unroll
                        for (int n = 0; n < 2; ++n) n2 += (v[bj][n][0] * v[bj][n][0] + v[bj][n][1] * v[bj][n][1]) + (v[bj][n][2] * v[bj][n][2] + v[bj][n][3] * v[bj][n][3]);
                    n2 += __shfl_xor(n2, 16); n2 += __shfl_xor(n2, 32);
                    nmax = fmaxf(nmax, n2); }
                if (kind == 3) {
#pragma unroll
                    for (int bj = 0; bj < 2; ++bj)
#pragma unroll
                        for (int n = 0; n < 2; ++n)
#pragma unroll
                            for (int i = 0; i < 4; ++i) v[bj][n][i] = __builtin_amdgcn_rcpf(1.0f + __expf(-v[bj][n][i])); }
                {
                    bf16_t* rowp = dst + (size_t)row * 1024 + col0;
#pragma unroll
                    for (int bj = 0; bj < 2; ++bj) { u32x4 w; w.x = cvt_pk_bf16(v[bj][0][0], v[bj][0][1]); w.y = cvt_pk_bf16(v[bj][0][2], v[bj][0][3]); w.z = cvt_pk_bf16(v[bj][1][0], v[bj][1][1]); w.w = cvt_pk_bf16(v[bj][1][2], v[bj][1][3]);
                        *(u32x4*)(rowp + bj * 32) = w; } }
            }
        if (kind < 2) {
            nmax = fmaxf(nmax, __shfl_xor(nmax, 1)); nmax = fmaxf(nmax, __shfl_xor(nmax, 2)); nmax = fmaxf(nmax, __shfl_xor(nmax, 4)); nmax = fmaxf(nmax, __shfl_xor(nmax, 8));
            if (fr == 0 && fq == 0) atomicMax(nrm + kind * 64 + (u.pm >> 5) * 16 + (u.pn & 3) * 4 + wc, __float_as_uint(nmax)); }
    }
};


template <class Epi, class Sched, bool ALIGN_EPI = false, bool SP2 = false>
__device__ __forceinline__ void gemm_phase(PG8_LAS unsigned char* lds, const Gemm g, const Sched& S, const Epi& E) {
    const int tid = mk_tid(), wid = __builtin_amdgcn_readfirstlane(tid >> 6), lane = tid & 63, wr = wid >> 2, wc = wid & 3, fr = lane & 15, fq = lane >> 4;
    const int K = g.K, nt = K / BK;
    unsigned voffA[2], voffB[2];
#pragma unroll
    for (int i = 0; i < 2; ++i) { int R, C; stage_rc(tid * 16 + i * 8192, R, C); const int Rb = Epi::PERM ? ((R & ~31) + perm32(R & 31)) : R;
        voffA[i] = (unsigned)(R * K + C) * 2u; voffB[i] = (unsigned)(Rb * K + C) * 2u; }
    const size_t kstep = (size_t)(BK * 2);
    const size_t hstep = (size_t)HALF * K * 2;
    const size_t tstep = 2 * hstep;
    const unsigned ldsw = (unsigned)wid * 1024u;
    const int aoff = lds_byte(wr * 64 + fr, fq * 8), boff = lds_byte(wc * 32 + fr, fq * 8);
#define PG8_SA(b, h) (((b) * 2 + (h)) * HTB)
#define PG8_SB(b, h) ((4 + (b) * 2 + (h)) * HTB)
#define PG8_STAGE(bufoff, gbase, voff) do { _Pragma("unroll") for (int _i = 0; _i < 2; ++_i) \
        __builtin_amdgcn_global_load_lds((const unsigned*)((const char*)(gbase) + (voff)[_i]), (PG8_LAS unsigned*)(lds + (bufoff) + ldsw + _i * 8192), 16, 0, 0); } while (0)
#define PG8_LDA(dst, b, h) do { _Pragma("unroll") for (int m = 0; m < 4; ++m) _Pragma("unroll") for (int k = 0; k < 2; ++k) dst[m][k] = *(const PG8_LAS bf16x8*)(lds + PG8_SA(b, h) + aoff + m * 2048 + k * 1024); } while (0)
#define PG8_LDB(dst, b, h) do { _Pragma("unroll") for (int n = 0; n < 2; ++n) _Pragma("unroll") for (int k = 0; k < 2; ++k) dst[n][k] = *(const PG8_LAS bf16x8*)(lds + PG8_SB(b, h) + boff + n * 2048 + k * 1024); } while (0)
#define PG8_MMA(ai, bj, At, Bt) do { __builtin_amdgcn_s_setprio(1); _Pragma("unroll") for (int m = 0; m < 4; ++m) _Pragma("unroll") for (int n = 0; n < 2; ++n) _Pragma("unroll") for (int k = 0; k < 2; ++k) \
        acc[ai][bj][m][n] = __builtin_amdgcn_mfma_f32_16x16x32_bf16(Bt[n][k], At[m][k], acc[ai][bj][m][n], 0, 0, 0); __builtin_amdgcn_s_setprio(0); } while (0)
#define PG8_WAIT_V(n) asm volatile("s_waitcnt vmcnt(" #n ")" ::: "memory")
#define PG8_WAIT_L(n) asm volatile("s_waitcnt lgkmcnt(" #n ")" ::: "memory")
#define PG8_BAR __builtin_amdgcn_s_barrier()
#define PG8_SCHED __builtin_amdgcn_sched_barrier(0)
    Unit cur, nxt; int ui = 0;
    if (!S.next(0, cur)) return;
    float prew[8]; E.pre(cur, wr, fr, prew);
    f32x4 acc[2][2][4][2];
#pragma unroll
    for (int a = 0; a < 2; ++a)
#pragma unroll
        for (int b = 0; b < 2; ++b)
#pragma unroll
            for (int m = 0; m < 4; ++m)
#pragma unroll
                for (int n = 0; n < 2; ++n) acc[a][b][m][n] = (f32x4){0.f, 0.f, 0.f, 0.f};
    bf16x8 At[4][2], B0[2][2], B1[2][2];
    const char* cA = (const char*)g.A + (size_t)cur.pm * tstep; const char* cB = (const char*)g.Bt + (size_t)cur.pn * tstep;
    S.a_ready(cur);
    if constexpr (SP2) {
        PG8_STAGE(PG8_SB(0, 0), cB, voffB); PG8_STAGE(PG8_SB(0, 1), cB + hstep, voffB); PG8_STAGE(PG8_SA(0, 0), cA, voffA); PG8_STAGE(PG8_SA(0, 1), cA + hstep, voffA);
        if (wr == 1) PG8_BAR;
        PG8_WAIT_V(2); PG8_BAR;
        PG8_STAGE(PG8_SB(1, 0), cB + kstep, voffB); PG8_STAGE(PG8_SA(1, 0), cA + kstep, voffA); PG8_STAGE(PG8_SB(1, 1), cB + hstep + kstep, voffB);
        PG8_WAIT_V(6); PG8_BAR;
    } else {
        PG8_STAGE(PG8_SB(0, 0), cB, voffB); PG8_STAGE(PG8_SA(0, 0), cA, voffA); PG8_STAGE(PG8_SB(0, 1), cB + hstep, voffB); PG8_STAGE(PG8_SA(0, 1), cA + hstep, voffA);
        if (wr == 1) PG8_BAR;
        PG8_WAIT_V(4); PG8_BAR;
        PG8_STAGE(PG8_SB(1, 0), cB + kstep, voffB); PG8_STAGE(PG8_SA(1, 0), cA + kstep, voffA); PG8_STAGE(PG8_SB(1, 1), cB + hstep + kstep, voffB);
        PG8_WAIT_V(6); PG8_BAR;
    }
    for (;;) {
        const bool has_next = S.next(ui + 1, nxt);
        const char* nA = has_next ? (const char*)g.A + (size_t)nxt.pm * tstep : cA; const char* nB = has_next ? (const char*)g.Bt + (size_t)nxt.pn * tstep : cB;
        for (int t = 0; t < nt; t += 2) {
            const bool last = (t == nt - 2);
            const char* a1 = cA + (size_t)(t + 1) * kstep;
            const char* a2 = last ? nA : cA + (size_t)(t + 2) * kstep; const char* b2 = last ? nB : cB + (size_t)(t + 2) * kstep;
            const char* a3 = a2 + kstep; const char* b3 = b2 + kstep;
            if (last && has_next) S.a_ready(nxt);
            if constexpr (SP2) {
            PG8_LDB(B0, 0, 0); PG8_LDB(B1, 0, 1); PG8_SCHED; PG8_LDA(At, 0, 0); PG8_STAGE(PG8_SA(1, 1), a1 + hstep, voffA);
            PG8_WAIT_V(8); PG8_WAIT_L(0); PG8_BAR; PG8_MMA(0, 0, At, B0); PG8_MMA(0, 1, At, B1); PG8_BAR; PG8_SCHED;
            PG8_LDA(At, 0, 1); PG8_STAGE(PG8_SB(0, 0), b2, voffB); PG8_STAGE(PG8_SB(0, 1), b2 + hstep, voffB); PG8_STAGE(PG8_SA(0, 0), a2, voffA);
            PG8_WAIT_V(8); PG8_WAIT_L(0); PG8_BAR; PG8_MMA(1, 0, At, B0); PG8_MMA(1, 1, At, B1); PG8_BAR; PG8_SCHED;
            PG8_LDB(B0, 1, 0); PG8_LDB(B1, 1, 1); PG8_SCHED; PG8_LDA(At, 1, 0); PG8_STAGE(PG8_SA(0, 1), a2 + hstep, voffA);
            PG8_WAIT_V(8); PG8_WAIT_L(0); PG8_BAR; PG8_MMA(0, 0, At, B0); PG8_MMA(0, 1, At, B1); PG8_BAR; PG8_SCHED;
            PG8_LDA(At, 1, 1); PG8_STAGE(PG8_SB(1, 0), b3, voffB); PG8_STAGE(PG8_SB(1, 1), b3 + hstep, voffB); PG8_STAGE(PG8_SA(1, 0), a3, voffA);
            PG8_WAIT_V(8); PG8_WAIT_L(0); PG8_BAR; PG8_MMA(1, 0, At, B0); PG8_MMA(1, 1, At, B1); PG8_BAR; PG8_SCHED;
            } else {
            PG8_LDB(B0, 0, 0); PG8_SCHED; PG8_LDA(At, 0, 0); PG8_STAGE(PG8_SA(1, 1), a1 + hstep, voffA);
            PG8_WAIT_L(8); PG8_BAR; PG8_WAIT_L(0); PG8_MMA(0, 0, At, B0); PG8_BAR; PG8_SCHED;
            PG8_LDB(B1, 0, 1); PG8_STAGE(PG8_SB(0, 0), b2, voffB);
            PG8_BAR; PG8_WAIT_L(0); PG8_MMA(0, 1, At, B1); PG8_BAR;
            PG8_LDA(At, 0, 1); PG8_STAGE(PG8_SA(0, 0), a2, voffA);
            PG8_BAR; PG8_WAIT_L(0); PG8_MMA(1, 0, At, B0); PG8_BAR; PG8_SCHED;
            PG8_STAGE(PG8_SB(0, 1), b2 + hstep, voffB);
            PG8_WAIT_V(6); PG8_BAR; PG8_MMA(1, 1, At, B1); PG8_BAR;
            PG8_LDB(B0, 1, 0); PG8_SCHED; PG8_LDA(At, 1, 0); PG8_STAGE(PG8_SA(0, 1), a2 + hstep, voffA);
            PG8_WAIT_L(8); PG8_BAR; PG8_WAIT_L(0); PG8_MMA(0, 0, At, B0); PG8_BAR; PG8_SCHED;
            PG8_LDB(B1, 1, 1); PG8_STAGE(PG8_SB(1, 0), b3, voffB);
            PG8_BAR; PG8_WAIT_L(0); PG8_MMA(0, 1, At, B1); PG8_BAR;
            PG8_LDA(At, 1, 1); PG8_STAGE(PG8_SA(1, 0), a3, voffA);
            PG8_BAR; PG8_WAIT_L(0); PG8_MMA(1, 0, At, B0); PG8_BAR; PG8_SCHED;
            PG8_STAGE(PG8_SB(1, 1), b3 + hstep, voffB);
            PG8_WAIT_V(6); PG8_BAR; PG8_MMA(1, 1, At, B1); PG8_BAR;
            }
        }
        if constexpr (ALIGN_EPI) { if (wr == 0) PG8_BAR; }
        if constexpr (!Epi::AFTER_DRAIN) { E(acc, cur, wr, wc, fr, fq, prew); S.done(cur); }
        if (!has_next) break;
#pragma unroll
        for (int a = 0; a < 2; ++a)
#pragma unroll
            for (int b = 0; b < 2; ++b)
#pragma unroll
                for (int m = 0; m < 4; ++m)
#pragma unroll
                    for (int n = 0; n < 2; ++n) acc[a][b][m][n] = (f32x4){0.f, 0.f, 0.f, 0.f};
        cur = nxt; cA = nA; cB = nB; ++ui;
        E.pre(cur, wr, fr, prew);
        if constexpr (ALIGN_EPI) { if (wr == 1) PG8_BAR; }
    }
    PG8_WAIT_V(0);
    if constexpr (!ALIGN_EPI) { if (wr == 0) PG8_BAR; }
    PG8_BAR;
    if constexpr (Epi::AFTER_DRAIN) { E.fused(acc, cur, wr, wc, fr, fq, lds, wid, lane); S.done(cur); }
#undef PG8_SA
#undef PG8_SB
#undef PG8_STAGE
#undef PG8_LDA
#undef PG8_LDB
#undef PG8_MMA
#undef PG8_WAIT_V
#undef PG8_WAIT_L
#undef PG8_BAR
#undef PG8_SCHED
}
}
#include <hip/hip_bf16.h>
#include <cmath>
namespace attn_body {
using bf16=__hip_bfloat16;
using bf16x8=__attribute__((ext_vector_type(8)))short;
using s16x4=__attribute__((ext_vector_type(4)))short;
using f32x16=__attribute__((ext_vector_type(16)))float;
using u32x4=__attribute__((ext_vector_type(4)))unsigned;
using f32x4_t=__attribute__((ext_vector_type(4)))float;
constexpr int BATCH=4,NHEAD=16,SEQ=8192,D=64,DM=NHEAD*D;
constexpr int NW=8,QBLK=32,QB=QBLK*NW,KVBLK=64,NQB=SEQ/QB;
constexpr int ATTN_PITCH=DM, ATTN_UNIT_ROWS=QB;
__device__ __forceinline__ int crow(int r,int hi){return (r&3)+8*(r>>2)+4*hi;}
#define SBAR() __builtin_amdgcn_sched_barrier(0)
__device__ __forceinline__ void cmask(f32x16&p0,f32x16&p1,int jb,int qrel,int hi){
  const float NEG=-INFINITY; int kb=64*jb+4*hi;
  #pragma unroll
  for(int r=0;r<16;++r){int kv=kb+(r&3)+8*(r>>2); if(kv>qrel)p0[r]=NEG; if(kv+32>qrel)p1[r]=NEG;}
}

constexpr int NSLOT=3, SLOTB=8192;
constexpr int LDS_K=0, LDS_V=NSLOT*SLOTB, LDS_WS=2*NSLOT*SLOTB, LDS_OST=LDS_WS+NW*64*4, LDS_BI=LDS_OST+NW*4096, LDS_BYTES=LDS_BI+NW*NSLOT*256;
constexpr float C2=0.125f*1.4426950408889634f;
__device__ __forceinline__ void glds16(const void*gsrc,unsigned lds_dst){unsigned keep;
  asm volatile("s_mov_b32 %0, m0\n\ts_mov_b32 m0, %2\n\ts_nop 0\n\tglobal_load_lds_dwordx4 %1, off\n\ts_mov_b32 m0, %0":"=&s"(keep):"v"(gsrc),"s"(lds_dst):"memory");}
__device__ __forceinline__ void glds4(const void*gsrc,unsigned lds_dst){unsigned keep;
  asm volatile("s_mov_b32 %0, m0\n\ts_mov_b32 m0, %2\n\ts_nop 0\n\tglobal_load_lds_dword %1, off\n\ts_mov_b32 m0, %0":"=&s"(keep):"v"(gsrc),"s"(lds_dst):"memory");}
__device__ __forceinline__ void glds16s(const void*sbase,unsigned voff,unsigned lds_dst){unsigned keep;
  asm volatile("s_mov_b32 %0, m0\n\ts_mov_b32 m0, %3\n\ts_nop 0\n\tglobal_load_lds_dwordx4 %1, %2\n\ts_mov_b32 m0, %0":"=&s"(keep):"v"(voff),"s"(sbase),"s"(lds_dst):"memory");}
__device__ __forceinline__ void glds4s(const void*sbase,unsigned voff,unsigned lds_dst){unsigned keep;
  asm volatile("s_mov_b32 %0, m0\n\ts_mov_b32 m0, %3\n\ts_nop 0\n\tglobal_load_lds_dword %1, %2\n\ts_mov_b32 m0, %0":"=&s"(keep):"v"(voff),"s"(sbase),"s"(lds_dst):"memory");}
__device__ __forceinline__ float max3f(float a,float b,float c){float r;asm("v_max3_f32 %0, %1, %2, %3":"=v"(r):"v"(a),"v"(b),"v"(c));return r;}
__device__ __forceinline__ float max2f(float a,float b){float r;asm("v_max_f32_e32 %0, %1, %2":"=v"(r):"v"(a),"v"(b));return r;}
__device__ __forceinline__ float fadd_s(float a,float b){float r;asm("v_add_f32_e32 %0, %1, %2":"=v"(r):"v"(a),"v"(b));return r;}
__device__ __forceinline__ float fsub_s(float a,float b){float r;asm("v_sub_f32_e32 %0, %1, %2":"=v"(r):"v"(a),"v"(b));return r;}
typedef float f32x2_t __attribute__((ext_vector_type(2))); typedef __bf16 bf16x2_t __attribute__((ext_vector_type(2)));
__device__ __forceinline__ unsigned cvtpk_s(float lo,float hi){f32x2_t v={lo,hi};bf16x2_t b=__builtin_convertvector(v,bf16x2_t);return __builtin_bit_cast(unsigned,b);}
#define WAIT_BAR(N) asm volatile("s_waitcnt vmcnt(" #N ") lgkmcnt(0)\n\ts_barrier":::"memory")

__device__ __forceinline__ void qkt(f32x16&p0,f32x16&p1,const char*Kslot,const bf16x8*qr,int r32,int hi){
  const char*kb=Kslot+hi*1024+r32*16;
  #pragma unroll
  for(int d0=0;d0<4;++d0){
    const bf16x8 b0=*reinterpret_cast<const bf16x8*>(kb+d0*2048);
    const bf16x8 b1=*reinterpret_cast<const bf16x8*>(kb+d0*2048+512);
    {p0=__builtin_amdgcn_mfma_f32_32x32x16_bf16(b0,qr[d0],p0,0,0,0);p1=__builtin_amdgcn_mfma_f32_32x32x16_bf16(b1,qr[d0],p1,0,0,0);}}
}
typedef __attribute__((address_space(3))) const char* lds_cptr;
typedef short v4i16_t __attribute__((ext_vector_type(4)));
__device__ __forceinline__ void kload8(bf16x8*kf,lds_cptr kp){
  kf[0]=*(const __attribute__((address_space(3))) bf16x8*)(kp);      kf[1]=*(const __attribute__((address_space(3))) bf16x8*)(kp+512);
  kf[2]=*(const __attribute__((address_space(3))) bf16x8*)(kp+2048); kf[3]=*(const __attribute__((address_space(3))) bf16x8*)(kp+2560);
  kf[4]=*(const __attribute__((address_space(3))) bf16x8*)(kp+4096); kf[5]=*(const __attribute__((address_space(3))) bf16x8*)(kp+4608);
  kf[6]=*(const __attribute__((address_space(3))) bf16x8*)(kp+6144); kf[7]=*(const __attribute__((address_space(3))) bf16x8*)(kp+6656);
}
__device__ __forceinline__ void kload2(bf16x8*kf,lds_cptr kp,int j){ kf[2*j]=*(const __attribute__((address_space(3))) bf16x8*)(kp+j*2048); kf[2*j+1]=*(const __attribute__((address_space(3))) bf16x8*)(kp+j*2048+512); }
__device__ __forceinline__ s16x4 vtr(lds_cptr p){ return __builtin_bit_cast(s16x4,__builtin_amdgcn_ds_read_tr16_b64_v4i16((__attribute__((address_space(3))) v4i16_t*)p)); }
__device__ __forceinline__ float rowmax(const f32x16&p0,const f32x16&p1){
  float a=max3f(p0[0],p0[1],p1[0]),b=max3f(p0[2],p0[3],p1[1]);a=max3f(a,p1[2],p1[3]);
  #pragma unroll
  for(int r=4;r<16;r+=4){a=max3f(a,p0[r],p0[r+1]);b=max3f(b,p0[r+2],p0[r+3]);a=max3f(a,p1[r],p1[r+1]);b=max3f(b,p1[r+2],p1[r+3]);}
  const float m=max2f(a,b);
  auto rr=__builtin_amdgcn_permlane32_swap(__float_as_uint(m),__float_as_uint(m),false,false);
  return max2f(__uint_as_float(rr[0]),__uint_as_float(rr[1]));
}
__device__ __forceinline__ void pv(f32x16*o,int vb,bf16x8 pa0,bf16x8 pa1,bf16x8 pa2,bf16x8 pa3){
  #pragma unroll
  for(int d0=0;d0<2;++d0){s16x4 lo[4],hi[4];
    #pragma unroll
    for(int ks=0;ks<4;++ks){
      asm volatile("ds_read_b64_tr_b16 %0,%1 offset:%c2":"=&v"(lo[ks]):"v"(vb),"i"(d0*4096+ks*1024):"memory");
      asm volatile("ds_read_b64_tr_b16 %0,%1 offset:%c2":"=&v"(hi[ks]):"v"(vb),"i"(d0*4096+ks*1024+512):"memory");}
    asm volatile("s_waitcnt lgkmcnt(0)":::"memory");SBAR();
    #define PK(k) (bf16x8){lo[k][0],lo[k][1],lo[k][2],lo[k][3],hi[k][0],hi[k][1],hi[k][2],hi[k][3]}
    o[d0]=__builtin_amdgcn_mfma_f32_32x32x16_bf16(pa0,PK(0),o[d0],0,0,0);
    o[d0]=__builtin_amdgcn_mfma_f32_32x32x16_bf16(pa1,PK(1),o[d0],0,0,0);
    o[d0]=__builtin_amdgcn_mfma_f32_32x32x16_bf16(pa2,PK(2),o[d0],0,0,0);
    o[d0]=__builtin_amdgcn_mfma_f32_32x32x16_bf16(pa3,PK(3),o[d0],0,0,0);
    #undef PK
  }
}

#ifndef ATTN_STORE16
#define ATTN_STORE16(p,v) (*(u32x4*)(p)=(v))
#endif
template<int THRL> __device__ __forceinline__ void attn_unit(int b,int h,int qb,const bf16*Q,const bf16*__restrict__ K,const bf16*__restrict__ V,const bf16*__restrict__ G,const float*__restrict__ CB,float moff,int t0,bf16*O,char*shm){
  const int tid=mk_tid(),lane=tid&63,r32=lane&31,hi=lane>>5; const int wid=__builtin_amdgcn_readfirstlane(tid>>6);
  const long rowbase=(long)b*SEQ; const int q0=qb*QB;
  const bf16*Qw=Q+(rowbase+q0+wid*QBLK)*DM+h*D;
  const bf16*Kh=K+(rowbase+(long)t0*KVBLK)*DM+h*D,*Vh=V+(rowbase+(long)t0*KVBLK)*DM+h*D;
  const unsigned lds0=(unsigned)(uintptr_t)shm;
  const unsigned koff=(unsigned)(lane*DM+wid*8)*2u;
  const unsigned voff=(unsigned)((16*(wid&3)+(lane>>2))*DM+(wid>>2)*32+(lane&3)*8)*2u;
  const float*CBh=CB+((long)b*NHEAD+h)*SEQ; const unsigned boff=(unsigned)lane*4u;
  const unsigned kdst=lds0+LDS_K+wid*1024, vdst=lds0+LDS_V+wid*1024, bdst=lds0+LDS_BI+wid*(NSLOT*256);
  #define DMA_K(t,slot) do{ glds16s(Kh+(long)(t)*KVBLK*DM,koff,(unsigned)__builtin_amdgcn_readfirstlane(kdst+(slot))); glds4s(CBh+(long)((t)+t0)*KVBLK,boff,(unsigned)__builtin_amdgcn_readfirstlane(bdst+((slot)>>5))); }while(0)
  #define DMA_V(t,slot) glds16s(Vh+(long)(t)*KVBLK*DM,voff,(unsigned)__builtin_amdgcn_readfirstlane(vdst+(slot)))
  const char*Kbase=shm+LDS_K; bf16x8 kf[8];
  const lds_cptr shm3=(lds_cptr)shm; const lds_cptr kp0=shm3+LDS_K+hi*1024+r32*16; const lds_cptr vp0=shm3+LDS_V+((lane>>4)&1)*32+(lane&3)*8+(4*hi+((lane&15)>>2))*64;
  const int NT=(q0+QB)/KVBLK-t0;
  DMA_K(0,0);DMA_V(0,0);DMA_K(1,SLOTB);
  bf16x8 qr[4];
  #pragma unroll
  for(int d0=0;d0<4;++d0)qr[d0]=*reinterpret_cast<const bf16x8*>(&Qw[(long)r32*DM+d0*16+hi*8]);
  float l_reg=0.f;f32x16 o[2];o[0]=f32x16{};o[1]=f32x16{};
  const float cqm=CBh[q0+wid*QBLK+r32]-moff;
  typedef __attribute__((address_space(3))) const f32x4_t* lds_f4p;
  const lds_cptr bp0=(lds_cptr)shm+LDS_BI+wid*(NSLOT*256)+hi*16;
  #define BIAS_RD(P0,P1,sl) do{ const lds_f4p bq_=(lds_f4p)(bp0+((sl)>>5)); \
    _Pragma("unroll") for(int a_=0;a_<4;++a_){ const f32x4_t x0_=bq_[2*a_]; P0[4*a_]=x0_[0];P0[4*a_+1]=x0_[1];P0[4*a_+2]=x0_[2];P0[4*a_+3]=x0_[3]; } \
    _Pragma("unroll") for(int a_=0;a_<4;++a_){ const f32x4_t x1_=bq_[8+2*a_]; P1[4*a_]=x1_[0];P1[4*a_+1]=x1_[1];P1[4*a_+2]=x1_[2];P1[4*a_+3]=x1_[3]; } \
    asm volatile("":"+v"(P0),"+v"(P1)); }while(0)
  #define BIAS_SUB(P0,P1) do{ _Pragma("unroll") for(int r_=0;r_<16;++r_){ P0[r_]=cqm-P0[r_]; P1[r_]=cqm-P1[r_]; } }while(0)
  #define BIAS_LD(P0,P1,sl) do{ BIAS_RD(P0,P1,sl); BIAS_SUB(P0,P1); }while(0)
  #define CMASK(P0,P1,t) do{int jb_=(t)-(NT-4); if(jb_>=0){ int ln_=mk_tid()&63; asm volatile("":"+v"(ln_)); cmask(P0,P1,jb_,wid*QBLK+(ln_&31),ln_>>5);} }while(0)
  f32x16 pA0,pA1,pB0,pB1;
  int sl_prev=0,sl_cur=0,sl_next=SLOTB;
  #define ROT() do{sl_prev=sl_cur;sl_cur=sl_next;sl_next=(sl_next==(NSLOT-1)*SLOTB)?0:sl_next+SLOTB;}while(0)
  DMA_K(2,2*SLOTB);
  WAIT_BAR(5);
  BIAS_LD(pA0,pA1,0);
  qkt(pA0,pA1,Kbase,qr,r32,hi);asm volatile("s_nop 15\n\ts_nop 7":"+v"(pA0),"+v"(pA1));CMASK(pA0,pA1,0);
  _Pragma("unroll") for(int r=0;r<16;++r)pA0[r]=__builtin_amdgcn_exp2f(pA0[r]);
  _Pragma("unroll") for(int r=0;r<16;++r)pA1[r]=__builtin_amdgcn_exp2f(pA1[r]);
  WAIT_BAR(0);
  DMA_K(3,0);DMA_V(1,SLOTB);
  ROT();
  kload8(kf,kp0+sl_cur);
  BIAS_RD(pB0,pB1,sl_cur);
  WAIT_BAR(3);
  s16x4 vlo[8],vhi[8]; u32x4 pw0,pw1,pw2,pw3;
  #define PKW(P,B) cvtpk_s(P[B],P[B+1])
  #define PAF(k) __builtin_bit_cast(bf16x8,pw##k)
  #define VFR(i) (bf16x8){vlo[i][0],vlo[i][1],vlo[i][2],vlo[i][3],vhi[i][0],vhi[i][1],vhi[i][2],vhi[i][3]}
  #define PIN(x) asm volatile("":"+v"(x))
  #define MX3(a,b,c) __builtin_fmaxf(__builtin_fmaxf((a),(b)),(c))
  #define GAPA(MF,A0,A1,A2,A3,W0,W1,PW) do{ MF; sacc+=A0; sacc+=A1; sacc+=A2; sacc+=A3; PIN(sacc); W0; W1; PIN(PW); SBAR(); }while(0)
  #define EX(v) __builtin_amdgcn_exp2f(v)
  #define GAPB(MF,X,B) do{ MF; X[B]=EX(X[B]); X[B+1]=EX(X[B+1]); X[B+2]=EX(X[B+2]); X[B+3]=EX(X[B+3]); PIN(X); SBAR(); }while(0)
  #define VRD(i) do{ vlo[i]=vtr(vp_+(((i)>>2)*4096+((i)&3)*1024)); vhi[i]=vtr(vp_+(((i)>>2)*4096+((i)&3)*1024+512)); }while(0)
  #define KRD(G,j) do{ if(G){ kload2(kf,kp0+sl_next,j); SBAR(); } }while(0)
  #define STEP(C0,C1,P0,P1,t,GK,GV,GL) do{ SBAR(); BIAS_SUB(C0,C1); SBAR(); \
    const lds_cptr vp_=vp0+sl_prev; \
    VRD(0); SBAR(); float sacc=(P0[0]+P0[1]); \
    GAPA(C0=__builtin_amdgcn_mfma_f32_32x32x16_bf16(kf[0],qr[0],C0,0,0,0), P0[2],P0[3],P0[4],P0[5],     pw0[0]=PKW(P0,0), pw0[1]=PKW(P0,2), pw0); \
    VRD(4); SBAR(); GAPA(C1=__builtin_amdgcn_mfma_f32_32x32x16_bf16(kf[1],qr[0],C1,0,0,0), P0[6],P0[7],P0[8],P0[9],     pw0[2]=PKW(P0,4), pw0[3]=PKW(P0,6), pw0); \
    VRD(1); SBAR(); GAPA(C0=__builtin_amdgcn_mfma_f32_32x32x16_bf16(kf[2],qr[1],C0,0,0,0),   P0[10],P0[11],P0[12],P0[13], pw1[0]=PKW(P0,8), pw1[1]=PKW(P0,10), pw1); \
    VRD(5); SBAR(); GAPA(C1=__builtin_amdgcn_mfma_f32_32x32x16_bf16(kf[3],qr[1],C1,0,0,0),   P0[14],P0[15],P1[0],P1[1],   pw1[2]=PKW(P0,12),pw1[3]=PKW(P0,14), pw1); \
    VRD(2); SBAR(); GAPA(C0=__builtin_amdgcn_mfma_f32_32x32x16_bf16(kf[4],qr[2],C0,0,0,0),   P1[2],P1[3],P1[4],P1[5],     pw2[0]=PKW(P1,0), pw2[1]=PKW(P1,2), pw2); \
    VRD(6); SBAR(); GAPA(C1=__builtin_amdgcn_mfma_f32_32x32x16_bf16(kf[5],qr[2],C1,0,0,0),   P1[6],P1[7],P1[8],P1[9],     pw2[2]=PKW(P1,4), pw2[3]=PKW(P1,6), pw2); \
    VRD(3); SBAR(); GAPA(C0=__builtin_amdgcn_mfma_f32_32x32x16_bf16(kf[6],qr[3],C0,0,0,0),   P1[10],P1[11],P1[12],P1[13], pw3[0]=PKW(P1,8), pw3[1]=PKW(P1,10), pw3); \
    VRD(7); SBAR(); GAPA(C1=__builtin_amdgcn_mfma_f32_32x32x16_bf16(kf[7],qr[3],C1,0,0,0),   P1[14],P1[15],0.f,0.f,       pw3[2]=PKW(P1,12),pw3[3]=PKW(P1,14), pw3); \
    l_reg+=sacc; \
    if(GK){DMA_K((t)+3,sl_cur);} if(GV){DMA_V((t)+1,sl_next);} \
    CMASK(C0,C1,t); \
    SBAR(); \
    GAPB(o[0]=__builtin_amdgcn_mfma_f32_32x32x16_bf16(PAF(0),VFR(0),o[0],0,0,0), C0,0); \
    GAPB(o[1]=__builtin_amdgcn_mfma_f32_32x32x16_bf16(PAF(0),VFR(4),o[1],0,0,0), C0,4); \
    KRD(GL,0); GAPB(o[0]=__builtin_amdgcn_mfma_f32_32x32x16_bf16(PAF(1),VFR(1),o[0],0,0,0), C0,8); \
    KRD(GL,1); GAPB(o[1]=__builtin_amdgcn_mfma_f32_32x32x16_bf16(PAF(1),VFR(5),o[1],0,0,0), C0,12); \
    KRD(GL,2); GAPB(o[0]=__builtin_amdgcn_mfma_f32_32x32x16_bf16(PAF(2),VFR(2),o[0],0,0,0), C1,0); \
    KRD(GL,3); GAPB(o[1]=__builtin_amdgcn_mfma_f32_32x32x16_bf16(PAF(2),VFR(6),o[1],0,0,0), C1,4); \
    GAPB(o[0]=__builtin_amdgcn_mfma_f32_32x32x16_bf16(PAF(3),VFR(3),o[0],0,0,0), C1,8); \
    GAPB(o[1]=__builtin_amdgcn_mfma_f32_32x32x16_bf16(PAF(3),VFR(7),o[1],0,0,0), C1,12); \
    if(GL){ BIAS_RD(P0,P1,sl_next); } \
    }while(0)
  int t=1;
  #undef CMASK
  #define CMASK(P0,P1,t) do{}while(0)
  for(;t+5<NT;t+=2){
    STEP(pB0,pB1,pA0,pA1,t,true,true,true);     WAIT_BAR(3); ROT();
    STEP(pA0,pA1,pB0,pB1,t+1,true,true,true);   WAIT_BAR(3); ROT();
  }
  #undef CMASK
  #define CMASK(P0,P1,t) do{int jb_=(t)-(NT-4); if(jb_>=0){ int ln_=mk_tid()&63; asm volatile("":"+v"(ln_)); cmask(P0,P1,jb_,wid*QBLK+(ln_&31),ln_>>5);} }while(0)
  #define ENDW(tt) do{ if((tt)+3<NT){WAIT_BAR(3);} else if((tt)+2<NT){WAIT_BAR(1);} else {WAIT_BAR(0);} }while(0)
  for(;t+1<NT;t+=2){
    STEP(pB0,pB1,pA0,pA1,t,(t+3<NT),(t+1<NT),(t+1<NT));       ENDW(t);   ROT();
    STEP(pA0,pA1,pB0,pB1,t+1,(t+4<NT),(t+2<NT),(t+2<NT));     ENDW(t+1); ROT();
  }
  STEP(pB0,pB1,pA0,pA1,NT-1,false,false,false);
  { float sacc=pB0[0]+pB0[1]; _Pragma("unroll") for(int r=2;r<16;++r)sacc+=pB0[r]; _Pragma("unroll") for(int r=0;r<16;++r)sacc+=pB1[r]; l_reg+=sacc;
    pw0=(u32x4){PKW(pB0,0),PKW(pB0,2),PKW(pB0,4),PKW(pB0,6)};pw1=(u32x4){PKW(pB0,8),PKW(pB0,10),PKW(pB0,12),PKW(pB0,14)};pw2=(u32x4){PKW(pB1,0),PKW(pB1,2),PKW(pB1,4),PKW(pB1,6)};pw3=(u32x4){PKW(pB1,8),PKW(pB1,10),PKW(pB1,12),PKW(pB1,14)};
    int lane_v=mk_tid()&63; asm volatile("":"+v"(lane_v)); const int vb0=(int)(lds0+LDS_V)+((lane_v>>4)&1)*32+(lane_v&3)*8+(4*(lane_v>>5)+((lane_v&15)>>2))*64;
    SBAR(); pv(o,vb0+sl_cur,PAF(0),PAF(1),PAF(2),PAF(3)); }
  #undef PKW
  #undef PAF
  #undef VFR
  #undef PIN
  #undef MX3
  #undef GAPA
  #undef GAPB
  #undef EX
  #undef VRD
  #undef KRD
  #undef STEP
  #undef ENDW
  {auto rr=__builtin_amdgcn_permlane32_swap(__float_as_uint(l_reg),__float_as_uint(l_reg),false,false);l_reg=__uint_as_float(rr[0])+__uint_as_float(rr[1]);}
  float*wsf=(float*)(shm+LDS_WS)+wid*64;
  if(hi==0)wsf[32+r32]=l_reg;asm volatile("s_waitcnt lgkmcnt(0)":::"memory");
  float rli[16];
  #pragma unroll
  for(int r=0;r<16;++r)rli[r]=__builtin_amdgcn_rcpf(wsf[32+crow(r,hi)]);
  int qb_l=qb,b_l=b,h_l=h; asm volatile("":"+s"(qb_l),"+s"(b_l),"+s"(h_l)); int lane_l=mk_tid()&63; asm volatile("":"+v"(lane_l));
  const long eoff=((long)b_l*SEQ+qb_l*QB+wid*QBLK)*DM+h_l*D; bf16*Ow=O+eoff; const bf16*Gw=G+eoff;
  u32x4 gpre[4];
  #pragma unroll
  for(int i=0;i<4;++i)gpre[i]=*(const u32x4*)(Gw+(long)(i*8+(lane_l>>3))*DM+(lane_l&7)*8);
  { bf16*stg=(bf16*)(shm+LDS_OST)+wid*2048;
    #pragma unroll
    for(int r=0;r<16;++r){const int orow=crow(r,hi);
      #pragma unroll
      for(int d0=0;d0<2;++d0)stg[orow*64+d0*32+r32]=__float2bfloat16(o[d0][r]*rli[r]);}
    asm volatile("s_waitcnt lgkmcnt(0)":::"memory");
    #pragma unroll
    for(int i=0;i<4;++i){const int row=i*8+(lane_l>>3),ch=lane_l&7; u32x4 v=*(const u32x4*)(stg+row*64+ch*8); const u32x4 g=gpre[i];
      _Pragma("unroll") for(int e=0;e<4;++e){ const float a0=__uint_as_float(v[e]<<16)*__uint_as_float(g[e]<<16), a1=__uint_as_float(v[e]&0xffff0000u)*__uint_as_float(g[e]&0xffff0000u); v[e]=cvtpk_s(a0,a1); }
      ATTN_STORE16(Ow+(long)row*DM+ch*8,v);} }
  asm volatile("s_waitcnt lgkmcnt(0)":::"memory");
  #undef DMA_K
  #undef DMA_V
  #undef CMASK
  #undef BIAS_LD
  #undef BIAS_RD
  #undef BIAS_SUB
  #undef ROT
}
constexpr int ATTN_LDS_BYTES=LDS_BYTES;
struct AttnTensors { const bf16* Q; const bf16* K; const bf16* V; const bf16* G; const float* CB; const float* gq; const float* gk; bf16* O; unsigned* queue; const unsigned* nrm; };
struct AttnUnit { int bh; int qb; };
struct StaticOrder {
  int vcu;
  __device__ __forceinline__ explicit StaticOrder(int grid,int block):vcu((block%8)*(grid/8)+block/8){}
  __device__ __forceinline__ bool next(int i,AttnUnit&u)const{ if(i>=8)return false; const int s=vcu&7,j=i&3; u.bh=(vcu>>3)+32*(i>>2); u.qb=(j==0)?s:(j==1)?15-s:(j==2)?16+s:31-s; return true; }
  __device__ __forceinline__ void a_ready(const AttnUnit&)const{}
  __device__ __forceinline__ void done(const AttnUnit&)const{}
};
template<class Sched,int THRL=8> __device__ __forceinline__ void attn_phase(char*lds,const AttnTensors&T,const Sched&S){
  AttnUnit u; const int lane_=mk_tid()&63;
  float ga=fabsf(T.gq[lane_]),gb=fabsf(T.gk[lane_]);
  #pragma unroll
  for(int o_=32;o_;o_>>=1){ga=fmaxf(ga,__shfl_xor(ga,o_));gb=fmaxf(gb,__shfl_xor(gb,o_));}
  const float moff=8.0f*1.4426950408889634f*ga*gb;
  volatile __attribute__((address_space(3))) unsigned* qw=(volatile __attribute__((address_space(3))) unsigned*)(lds+LDS_BYTES);
  unsigned nxt=0u; if(mk_tid()==0) nxt=__hip_atomic_fetch_add(T.queue,1u,__ATOMIC_RELAXED,__HIP_MEMORY_SCOPE_AGENT);
  for(;;){
    if(mk_tid()==0){ *qw=nxt; nxt=__hip_atomic_fetch_add(T.queue,1u,__ATOMIC_RELAXED,__HIP_MEMORY_SCOPE_AGENT); }
    asm volatile("s_waitcnt lgkmcnt(0)\n\ts_barrier":::"memory");
    const unsigned idx=*qw;
    if(idx>=(unsigned)(BATCH*NHEAD*NQB)) break;
    const int qb=NQB-1-(int)(idx/(BATCH*NHEAD)), bh=(int)(idx%(BATCH*NHEAD));
    const float* cbh=T.CB+(long)bh*SEQ; const float cq0=cbh[qb*QB]; const int ntf=4*qb+4;
    const float nq2=__uint_as_float(T.nrm[bh]), nk2=__uint_as_float(T.nrm[64+bh]);
    const float cA=cbh[64*lane_+63], cB=cbh[64*(lane_+64)+63];
    const float lim=__builtin_amdgcn_exp2f(-26.0f-2.02f*__builtin_sqrtf(nq2*nk2));
    float eA=(lane_<ntf)?__builtin_amdgcn_exp2f(cq0-cA):0.f, eB=(lane_+64<ntf)?__builtin_amdgcn_exp2f(cq0-cB):0.f;
    #pragma unroll
    for(int o_=1;o_<64;o_<<=1){ const float a_=__shfl_up(eA,o_), b_=__shfl_up(eB,o_); if(lane_>=o_){eA+=a_;eB+=b_;} }
    eB+=__shfl(eA,63);
    const bool s0=(lane_<ntf)&(eA<=lim), s1=(lane_+64<ntf)&(eB<=lim);
    int t0=__popcll(__ballot(s0))+__popcll(__ballot(s1)); t0&=~1; if(t0>ntf-4)t0=ntf-4;
    attn_unit<THRL>(bh/NHEAD,bh%NHEAD,qb,T.Q,T.K,T.V,T.G,T.CB,moff,t0,T.O,lds);
  }
}
#undef SBAR
#undef WAIT_BAR
}
constexpr int NWAVES = 8;
constexpr int BATCH = 4, SEQ = 8192, D = 1024, FF = 4096, M = BATCH * SEQ;
constexpr int N0P = 3072, N1P = 4096;
constexpr int GH = 4, GDK = 128, GDV = 256, GC = 64, GNC = SEQ / GC, GUNITS = BATCH * GH * GNC;
constexpr float EPS = 1e-6f, LOG2E = 1.4426950408889634f;
constexpr size_t MiB = 1u << 20;
constexpr size_t WS_RSTD0 = 1 * MiB, WS_SSQ = 1 * MiB + 131072  , WS_LF = 2 * MiB, WS_CB = 4 * MiB, WS_DEC = 6 * MiB, WS_GLB = 7 * MiB  , WS_WG0 = 8 * MiB  , WS_WF1 = 8 * MiB + 65536;
constexpr size_t WS_WIN0 = 12 * MiB, WS_WOUT0 = 19 * MiB, WS_W1A = 21 * MiB, WS_W2A = 29 * MiB, WS_WIN1 = 37 * MiB, WS_WOUT1 = 46 * MiB, WS_W1B = 48 * MiB, WS_W2B = 56 * MiB;
constexpr size_t WS_XB = 64 * MiB, WS_PH = 128 * MiB, WS_PROJ0 = WS_PH, WS_Y0 = 336 * MiB, WS_U = WS_PH, WS_Q = 128 * MiB, WS_K = 192 * MiB, WS_V = 256 * MiB, WS_G = 320 * MiB, WS_O = 384 * MiB, WS_END = 448 * MiB;
constexpr int RING_BYTES = 131072, LDS_BYTES = 147456;
#define LAS __attribute__((address_space(3)))
typedef unsigned short bf16;
typedef unsigned v4u __attribute__((ext_vector_type(4)));
typedef unsigned v2u __attribute__((ext_vector_type(2)));
typedef float f32x4 __attribute__((ext_vector_type(4)));
typedef short bf16x8 __attribute__((ext_vector_type(8)));
typedef short s16x4 __attribute__((ext_vector_type(4)));
#define LDS_WAIT() asm volatile("s_waitcnt lgkmcnt(0)" ::: "memory")
typedef float f32x2_hw __attribute__((ext_vector_type(2))); typedef __bf16 bf16x2_hw __attribute__((ext_vector_type(2)));
__device__ __forceinline__ unsigned pk2(float lo, float hi) { const f32x2_hw v = {lo, hi}; return __builtin_bit_cast(unsigned, __builtin_convertvector(v, bf16x2_hw)); }
__device__ __forceinline__ unsigned f2bf(float f) { return pk2(f, 0.f) & 0xffffu; }
__device__ __forceinline__ float frcp(float x) { return __builtin_amdgcn_rcpf(x); }
__device__ __forceinline__ float frsq(float x) { return __builtin_amdgcn_rsqf(x); }
__device__ __forceinline__ float bf2f(bf16 v) { return __uint_as_float((unsigned)v << 16); }
__device__ __forceinline__ float bflo(unsigned w) { return __uint_as_float(w << 16); }
__device__ __forceinline__ float bfhi(unsigned w) { return __uint_as_float(w & 0xffff0000u); }
__device__ __forceinline__ float wave_sum(float v) {
#pragma unroll
    for (int o = 1; o < 64; o <<= 1) v += __shfl_xor(v, o);
    return v;
}
__device__ __forceinline__ float fexp(float x) { return __builtin_amdgcn_exp2f(x * 1.4426950408889634f); }
__device__ __forceinline__ float log_sigmoid(float z) { return fminf(z, 0.f) - __logf(1.0f + fexp(-fabsf(z))); }

struct Args { const float* in[20]; float* out; unsigned char* ws; int ph_lo, ph_hi; };
struct Frame { LAS unsigned char* lds; int tid, lane, wave, vcu, G; };

__device__ __forceinline__ int col_src(int mode, int c, int Norig) {
    if (mode == 0) return c < Norig ? c : -1;
    if (mode == 2) return c < 16 ? 3072 + c : -1;
    return c < 3072 ? c : (c < 4096 ? c + 16 : (c < 4112 ? c - 1024 : -1));
}
__device__ __forceinline__ void p0_transpose_item(const float* W, int K, int Norig, int Npad, int mode, const float* gain, bf16* WT, LAS float* scr, int item, int lane) {
    const int nblk = Npad / 32, kb = item / nblk, nb = item % nblk, k0 = 64 * kb, n0 = 32 * nb;
    const int c4 = lane & 7, sc = col_src(mode, n0 + 4 * c4, Norig);
    f32x4 v[8]; float gk[8];
    const char* wb = (const char*)(W + (size_t)k0 * Norig); const unsigned wo = (unsigned)((lane >> 3) * Norig + (sc >= 0 ? sc : 0)) * 4u;
    const float* gp = gain ? gain + k0 : W;
#pragma unroll
    for (int i = 0; i < 8; ++i) { v[i] = *(const f32x4*)(wb + (size_t)(8 * i) * Norig * 4 + wo); gk[i] = gp[8 * i + (lane >> 3)]; }
#pragma unroll
    for (int i = 0; i < 8; ++i) { const int kk = 8 * i + (lane >> 3); f32x4 w = v[i]; const float gm = gain ? gk[i] : 1.0f; w = w * (sc >= 0 ? gm : 0.0f);
        LAS float* d = scr + kk * 33 + 4 * c4; d[0] = w[0]; d[1] = w[1]; d[2] = w[2]; d[3] = w[3]; }
    LDS_WAIT(); asm volatile("" ::: "memory");
    const int c = lane & 7;
    const int prow0 = (n0 & ~255) + 128 * ((n0 >> 5) & 1) + 32 * ((n0 >> 6) & 3);
#pragma unroll
    for (int j = 0; j < 4; ++j) { const int n = (lane >> 3) + 8 * j; const LAS float* s = scr + (8 * c) * 33 + n;
        v4u o; o.x = pk2(s[0 * 33], s[1 * 33]); o.y = pk2(s[2 * 33], s[3 * 33]); o.z = pk2(s[4 * 33], s[5 * 33]); o.w = pk2(s[6 * 33], s[7 * 33]);
        *(v4u*)(WT + (size_t)(prow0 + n) * K + k0 + 8 * c) = o; }
    LDS_WAIT(); asm volatile("" ::: "memory");
}
__device__ __forceinline__ void p0_prologue(Frame& F, const Args& a) {
    LAS float* scr = (LAS float*)(F.lds + F.wave * 16384);
    unsigned char* ws = a.ws;
    const int gw = F.vcu * NWAVES + F.wave, NGW = F.G * NWAVES;
    constexpr int I0 = (D / 64) * (N0P / 32), I1 = (D / 64) * (D / 32), I2 = (D / 64) * (FF / 32), I3 = (FF / 64) * (D / 32), I4 = (D / 64) * (N1P / 32);
    constexpr int IT = D / 64;
    constexpr int NITEMS = I0 + I1 + I2 + I3 + I4 + I1 + I2 + I3 + 2 * IT;
#pragma unroll 1
    for (int it = gw; it < NITEMS; it += NGW) {
        int r = it;
        if (r < I0) { p0_transpose_item(a.in[2], D, 3088, N0P, 0, a.in[1], (bf16*)(ws + WS_WIN0), scr, r, F.lane); continue; } r -= I0;
        if (r < I1) { p0_transpose_item(a.in[6], D, D, D, 0, nullptr, (bf16*)(ws + WS_WOUT0), scr, r, F.lane); continue; } r -= I1;
        if (r < I2) { p0_transpose_item(a.in[8], D, FF, FF, 0, a.in[7], (bf16*)(ws + WS_W1A), scr, r, F.lane); continue; } r -= I2;
        if (r < I3) { p0_transpose_item(a.in[9], FF, D, D, 0, nullptr, (bf16*)(ws + WS_W2A), scr, r, F.lane); continue; } r -= I3;
        if (r < I4) { p0_transpose_item(a.in[11], D, 4112, N1P, 1, a.in[10], (bf16*)(ws + WS_WIN1), scr, r, F.lane); continue; } r -= I4;
        if (r < I1) { p0_transpose_item(a.in[15], D, D, D, 0, nullptr, (bf16*)(ws + WS_WOUT1), scr, r, F.lane); continue; } r -= I1;
        if (r < I2) { p0_transpose_item(a.in[17], D, FF, FF, 0, a.in[16], (bf16*)(ws + WS_W1B), scr, r, F.lane); continue; } r -= I2;
        if (r < I3) { p0_transpose_item(a.in[18], FF, D, D, 0, nullptr, (bf16*)(ws + WS_W2B), scr, r, F.lane); continue; } r -= I3;
        if (r < IT) { p0_transpose_item(a.in[2], D, 3088, 32, 2, a.in[1], (bf16*)(ws + WS_WG0), scr, r, F.lane); continue; } r -= IT;
        p0_transpose_item(a.in[11], D, 4112, 32, 2, a.in[10], (bf16*)(ws + WS_WF1), scr, r, F.lane);
    }
    const float* x = a.in[0]; bf16* XB = (bf16*)(ws + WS_XB); float* rstd0 = (float*)(ws + WS_RSTD0);
    { int m = 2 * gw; f32x4 v[8];
      if (m < M) { const f32x4* xr = (const f32x4*)(x + (size_t)m * D) + F.lane;
#pragma unroll
          for (int j = 0; j < 8; ++j) v[j] = xr[64 * j]; }
#pragma unroll 1
      for (; m < M; m += 2 * NGW) { const int mn = m + 2 * NGW; f32x4 w[8];
          if (mn < M) { const f32x4* xn = (const f32x4*)(x + (size_t)mn * D) + F.lane;
#pragma unroll
              for (int j = 0; j < 8; ++j) w[j] = xn[64 * j]; }
          float s0 = 0.f, s1 = 0.f;
#pragma unroll
          for (int j = 0; j < 4; ++j) { s0 += (v[j].x * v[j].x + v[j].y * v[j].y) + (v[j].z * v[j].z + v[j].w * v[j].w); s1 += (v[4 + j].x * v[4 + j].x + v[4 + j].y * v[4 + j].y) + (v[4 + j].z * v[4 + j].z + v[4 + j].w * v[4 + j].w); }
          s0 = wave_sum(s0); s1 = wave_sum(s1);
          if (F.lane == 0) { rstd0[m] = frsq(s0 * (1.0f / D) + EPS); rstd0[m + 1] = frsq(s1 * (1.0f / D) + EPS); }
          v2u* o8 = (v2u*)(XB + (size_t)m * D) + F.lane;
#pragma unroll
          for (int j = 0; j < 8; ++j) { v2u pw; pw.x = pk2(v[j].x, v[j].y); pw.y = pk2(v[j].z, v[j].w); o8[64 * j] = pw; }
#pragma unroll
          for (int j = 0; j < 8; ++j) v[j] = w[j]; } }
    float* ssq = (float*)(ws + WS_SSQ);
    for (int i = (F.vcu * NWAVES * 64) + F.tid; i < 4 * M; i += F.G * NWAVES * 64) ssq[i] = 0.f;
}

struct GlaPre { v4u v[4]; v4u q[2]; v4u k[2]; v4u g; };
template <bool WANT_Q> __device__ __forceinline__ void gla_prefetch(GlaPre& P, const bf16* prow, const bf16* grow, int h, int tid) {
    const char* pb = (const char*)prow;
    const unsigned ov = (unsigned)(tid >> 5) * (N0P * 2) + (unsigned)(tid & 31) * 16, ok = (unsigned)(tid >> 4) * (N0P * 2) + (unsigned)(tid & 15) * 16, og = (unsigned)(tid & 127) * 16;
#pragma unroll
    for (int i = 0; i < 4; ++i) P.v[i] = *(const v4u*)(pb + ((size_t)(16 * i) * N0P + 1024 + h * 256) * 2 + ov);
#pragma unroll
    for (int i = 0; i < 2; ++i) { P.k[i] = *(const v4u*)(pb + ((size_t)(32 * i) * N0P + 512 + h * 128) * 2 + ok); if (WANT_Q) P.q[i] = *(const v4u*)(pb + ((size_t)(32 * i) * N0P + h * 128) * 2 + ok); }
    P.g = *(const v4u*)((const char*)grow + og);
}
constexpr int VSTR = 544, QSTR = 272, KDSTR = 144;
template <bool WANT_Q> __device__ __forceinline__ void gla_stage(const GlaPre& P, LAS unsigned char* Vs, LAS unsigned char* Ks, LAS unsigned char* Qs, LAS float* gl, int tid) {
#pragma unroll
    for (int i = 0; i < 4; ++i) { const int p = tid + 512 * i, t = p >> 5, ch = p & 31; *(LAS v4u*)(Vs + t * VSTR + ch * 16) = P.v[i]; }
#pragma unroll
    for (int i = 0; i < 2; ++i) { const int p = tid + 512 * i, t = p >> 4, ch = p & 15; *(LAS v4u*)(Ks + t * QSTR + ch * 16) = P.k[i]; if (WANT_Q) *(LAS v4u*)(Qs + t * QSTR + ch * 16) = P.q[i]; }
    if (tid < 128) *(LAS v4u*)((LAS unsigned char*)gl + tid * 16) = P.g;
}
#define MFMA16(a, b, c) __builtin_amdgcn_mfma_f32_16x16x32_bf16(a, b, c, 0, 0, 0)
__device__ __forceinline__ void gla_gate_mfma(const bf16x8 wuf, float bias, const LAS unsigned char* gl16, int l15, int g, float (&bl)[4][4], float& blast) {
    float carry = 0.f;
#pragma unroll
    for (int mt = 0; mt < 4; ++mt) {
        bf16x8 af = *(const LAS bf16x8*)(gl16 + (16 * mt + l15) * 32 + (g & 1) * 16); if (g >= 2) af = (bf16x8){0, 0, 0, 0, 0, 0, 0, 0};
        const f32x4 z = MFMA16(af, wuf, ((f32x4){bias, bias, bias, bias}));
        float p[4]; float run = 0.f;
#pragma unroll
        for (int r = 0; r < 4; ++r) { run += log_sigmoid(z[r]) * (1.0f / 16.0f); p[r] = run; }
        const float x1 = __shfl_up(run, 16), x2 = __shfl_up(run, 32), x3 = __shfl_up(run, 48);
        const float e = (g >= 1 ? x1 : 0.f) + (g >= 2 ? x2 : 0.f) + (g >= 3 ? x3 : 0.f);
        float tt = run + __shfl_xor(run, 16); tt += __shfl_xor(tt, 32);
#pragma unroll
        for (int r = 0; r < 4; ++r) bl[mt][r] = carry + e + p[r];
        carry += tt; }
    blast = carry;
}
__device__ __forceinline__ bf16x8 gla_wu_frag(const float* wup, int h, int w, int l15, int g) {
    const float* p = wup + (size_t)(8 * (g & 1)) * 512 + h * 128 + 16 * w + l15; float v[8];
#pragma unroll
    for (int j = 0; j < 8; ++j) v[j] = p[j * 512];
    v4u o; o.x = pk2(v[0], v[1]); o.y = pk2(v[2], v[3]); o.z = pk2(v[4], v[5]); o.w = pk2(v[6], v[7]);
    if (g >= 2) o = (v4u){0u, 0u, 0u, 0u};
    return __builtin_bit_cast(bf16x8, o);
}
__device__ __forceinline__ s16x4 tr16(const LAS unsigned char* p) { typedef short v4i16_t __attribute__((ext_vector_type(4))); return __builtin_bit_cast(s16x4, __builtin_amdgcn_ds_read_tr16_b64_v4i16((LAS v4i16_t*)p)); }
__device__ __forceinline__ void gla_pass_a(Frame& F, const Args& a) {
    const int tid = F.tid, lane = F.lane, w = F.wave, l15 = lane & 15, g = lane >> 4, c = tid & 127, tg = tid >> 7;
    LAS float* gl = (LAS float*)F.lds; LAS float* tot = (LAS float*)(F.lds + 4096); LAS unsigned char* Ks = F.lds + 8192; LAS unsigned char* KdT = F.lds + 25600; LAS unsigned char* Vs = F.lds + 45056;
    const bf16* proj = (const bf16*)(a.ws + WS_PROJ0); const bf16* glb = (const bf16*)(a.ws + WS_GLB);
    GlaPre P; int unit = F.vcu;
    if (unit < GUNITS) { const int bh = unit >> 7, n = unit & 127; gla_prefetch<false>(P, proj + ((size_t)(bh >> 2) * SEQ + (size_t)n * GC) * N0P, glb + ((size_t)(bh >> 2) * SEQ + (size_t)n * GC) * 16, bh & 3, tid); }
    for (; unit < GUNITS; unit += F.G) {
        const int bh = unit >> 7, h = bh & 3;
        gla_stage<false>(P, Vs, Ks, nullptr, gl, tid);
        const bf16x8 wuf = gla_wu_frag(a.in[3], h, w, l15, g); const float bias = a.in[4][h * 128 + 16 * w + l15];
        __syncthreads();
        { int nu = unit + F.G; if (nu >= GUNITS) nu = unit;        { const int nbh = nu >> 7, nn = nu & 127; gla_prefetch<false>(P, proj + ((size_t)(nbh >> 2) * SEQ + (size_t)nn * GC) * N0P, glb + ((size_t)(nbh >> 2) * SEQ + (size_t)nn * GC) * 16, nbh & 3, tid); } }
        float bl[4][4], blast;
        gla_gate_mfma(wuf, bias, (const LAS unsigned char*)gl, l15, g, bl, blast);
        { const int cc = 16 * w + l15;
#pragma unroll
          for (int mt = 0; mt < 4; ++mt) { float kd[4];
#pragma unroll
              for (int r = 0; r < 4; ++r) kd[r] = bf2f(*(const LAS bf16*)(Ks + (16 * mt + 4 * g + r) * QSTR + cc * 2)) * fexp(blast - bl[mt][r]);
              v2u o; o.x = pk2(kd[0], kd[1]); o.y = pk2(kd[2], kd[3]); *(LAS v2u*)(KdT + cc * KDSTR + (16 * mt + 4 * g) * 2) = o; }
          if (g == 0) ((float*)(a.ws + WS_DEC))[(size_t)unit * 128 + cc] = fexp(blast); }
        __syncthreads();
        f32x4 acc[2][8];
#pragma unroll
        for (int mt = 0; mt < 2; ++mt)
#pragma unroll
            for (int nt = 0; nt < 8; ++nt) acc[mt][nt] = (f32x4){0.f, 0.f, 0.f, 0.f};
#pragma unroll
        for (int s = 0; s < 2; ++s) { bf16x8 vf[2];
#pragma unroll
            for (int mt = 0; mt < 2; ++mt) { const LAS unsigned char* p = Vs + (32 * s + 4 * g + (l15 >> 2)) * VSTR + (32 * w + 16 * mt + 4 * (l15 & 3)) * 2;
                const s16x4 lo = tr16(p), hi = tr16(p + 16 * VSTR); vf[mt] = (bf16x8){lo[0], lo[1], lo[2], lo[3], hi[0], hi[1], hi[2], hi[3]}; }
#pragma unroll
            for (int nt = 0; nt < 8; ++nt) { const LAS unsigned char* p = KdT + (16 * nt + l15) * KDSTR + (32 * s + 4 * g) * 2;
                const s16x4 lo = *(const LAS s16x4*)p, hi = *(const LAS s16x4*)(p + 32); const bf16x8 kf = (bf16x8){lo[0], lo[1], lo[2], lo[3], hi[0], hi[1], hi[2], hi[3]};
#pragma unroll
                for (int mt = 0; mt < 2; ++mt) acc[mt][nt] = MFMA16(kf, vf[mt], acc[mt][nt]); } }
        bf16* S = (bf16*)a.out + (size_t)unit * 256 * 128;
#pragma unroll
        for (int mt = 0; mt < 2; ++mt)
#pragma unroll
            for (int nt = 0; nt < 8; ++nt) { v2u o; o.x = pk2(acc[mt][nt][0], acc[mt][nt][1]); o.y = pk2(acc[mt][nt][2], acc[mt][nt][3]);
                *(v2u*)((char*)S + (size_t)(32 * w + 16 * mt) * 256 + nt * 32 + (unsigned)(l15 * 256 + g * 8)) = o; }
        __syncthreads();
    }
}
__device__ __forceinline__ void gla_scan(Frame& F, const Args& a) {
    bf16* S = (bf16*)a.out; const float* dec = (const float*)(a.ws + WS_DEC);
    for (int id = F.vcu * 512 + F.tid; id < 16 * 256 * 32; id += F.G * 512) { const int c4 = id & 31, dv = (id >> 5) & 255, bh = id >> 13;
        float st[4] = {0.f, 0.f, 0.f, 0.f};
        v2u sl[16]; f32x4 d[16];
        { const char* pb = (const char*)(S + (((size_t)bh * GNC) * 256 + dv) * 128 + c4 * 4); const char* db = (const char*)(dec + ((size_t)bh * GNC) * 128 + c4 * 4);
#pragma unroll
          for (int j = 0; j < 16; ++j) { sl[j] = *(const v2u*)(pb + (size_t)j * 65536); d[j] = *(const f32x4*)(db + (size_t)j * 512); } }
#pragma unroll 1
        for (int n0 = 0; n0 < GNC; n0 += 16) {
            char* pb = (char*)(S + (((size_t)bh * GNC + n0) * 256 + dv) * 128 + c4 * 4);
            v2u sn[16]; f32x4 dn[16];
            if (n0 + 16 < GNC) { const char* pn = pb + (size_t)16 * 65536; const char* dnb = (const char*)(dec + ((size_t)bh * GNC + n0 + 16) * 128 + c4 * 4);
#pragma unroll
                for (int j = 0; j < 16; ++j) { sn[j] = *(const v2u*)(pn + (size_t)j * 65536); dn[j] = *(const f32x4*)(dnb + (size_t)j * 512); } }
#pragma unroll
            for (int j = 0; j < 16; ++j) { v2u o; o.x = pk2(st[0], st[1]); o.y = pk2(st[2], st[3]); *(v2u*)(pb + (size_t)j * 65536) = o;
                st[0] = st[0] * d[j][0] + bflo(sl[j].x); st[1] = st[1] * d[j][1] + bfhi(sl[j].x); st[2] = st[2] * d[j][2] + bflo(sl[j].y); st[3] = st[3] * d[j][3] + bfhi(sl[j].y); }
#pragma unroll
            for (int j = 0; j < 16; ++j) { sl[j] = sn[j]; d[j] = dn[j]; } } }
}
__device__ __forceinline__ void gla_pass_c(Frame& F, const Args& a) {
    const int tid = F.tid, lane = F.lane, w = F.wave, l15 = lane & 15, g = lane >> 4, c = tid & 127, tg = tid >> 7;
    LAS float* gl = (LAS float*)F.lds; LAS float* tot = (LAS float*)(F.lds + 4096); LAS float* ssqx = (LAS float*)(F.lds + 6144);
    LAS unsigned char* Qs = F.lds + 8192; LAS unsigned char* Ks = F.lds + 25600; LAS unsigned char* Vs = F.lds + 43008;
    const bf16* proj = (const bf16*)(a.ws + WS_PROJ0); const bf16* glb = (const bf16*)(a.ws + WS_GLB);
    const float qsc = 0.08838834764831845f;
    f32x4 gon[2];
#pragma unroll
    for (int nt = 0; nt < 2; ++nt) gon[nt] = *(const f32x4*)(a.in[5] + 32 * w + 16 * nt + 4 * g);
    GlaPre P; int unit = F.vcu;
    if (unit < GUNITS) { const int bh = unit >> 7, n = unit & 127; gla_prefetch<true>(P, proj + ((size_t)(bh >> 2) * SEQ + (size_t)n * GC) * N0P, glb + ((size_t)(bh >> 2) * SEQ + (size_t)n * GC) * 16, bh & 3, tid); }
    for (; unit < GUNITS; unit += F.G) {
        const int bh = unit >> 7, n = unit & 127, b = bh >> 2, h = bh & 3; const size_t row0 = (size_t)b * SEQ + (size_t)n * GC;
        const bf16* prow = proj + row0 * N0P;
        gla_stage<true>(P, Vs, Ks, Qs, gl, tid);
        const bf16x8 wuf = gla_wu_frag(a.in[3], h, w, l15, g); const float bias = a.in[4][h * 128 + 16 * w + l15];
        __syncthreads();
        { int nu = unit + F.G; if (nu >= GUNITS) nu = unit;        { const int nbh = nu >> 7, nn = nu & 127; gla_prefetch<true>(P, proj + ((size_t)(nbh >> 2) * SEQ + (size_t)nn * GC) * N0P, glb + ((size_t)(nbh >> 2) * SEQ + (size_t)nn * GC) * 16, nbh & 3, tid); } }
        float bl[4][4], blast;
        gla_gate_mfma(wuf, bias, (const LAS unsigned char*)gl, l15, g, bl, blast);
        const bf16* Sp = (const bf16*)a.out + (size_t)unit * 256 * 128;
        bf16x8 Sf[4][2]; v2u rv[4][2];
        { const char* sb = (const char*)Sp + (size_t)(32 * w) * 256; const unsigned so = (unsigned)l15 * 256 + (unsigned)g * 16;
#pragma unroll
          for (int kc = 0; kc < 4; ++kc)
#pragma unroll
              for (int nt = 0; nt < 2; ++nt) Sf[kc][nt] = *(const bf16x8*)(sb + nt * 4096 + kc * 64 + so);
          const char* rb = (const char*)prow + (size_t)(2048 + h * 256 + 32 * w) * 2; const unsigned ro = (unsigned)l15 * (N0P * 2) + (unsigned)g * 8;
#pragma unroll
          for (int it = 0; it < 4; ++it)
#pragma unroll
              for (int nt = 0; nt < 2; ++nt) rv[it][nt] = *(const v2u*)(rb + (size_t)(16 * it) * (N0P * 2) + nt * 32 + ro); }
        { const int cc = 16 * w + l15;
#pragma unroll
          for (int mt = 0; mt < 4; ++mt)
#pragma unroll
              for (int r = 0; r < 4; ++r) { const int t = 16 * mt + 4 * g + r; LAS bf16* qp = (LAS bf16*)(Qs + t * QSTR + cc * 2); LAS bf16* kp = (LAS bf16*)(Ks + t * QSTR + cc * 2);
                  *qp = (bf16)f2bf(bf2f(*qp) * qsc * fexp(bl[mt][r])); *kp = (bf16)f2bf(bf2f(*kp) * fexp(-bl[mt][r])); } }
        __syncthreads();
        v4u pf[4][2];
#pragma unroll
        for (int it = 0; it < 4; ++it) { pf[it][0] = (v4u){0u, 0u, 0u, 0u}; pf[it][1] = (v4u){0u, 0u, 0u, 0u}; }
#pragma unroll
        for (int it = 0; it < 4; ++it) { bf16x8 Qf[4];
#pragma unroll
            for (int kc = 0; kc < 4; ++kc) Qf[kc] = *(const LAS bf16x8*)(Qs + (16 * it + l15) * QSTR + (32 * kc + 8 * g) * 2);
#pragma unroll
            for (int jt = 0; jt <= it; ++jt) { f32x4 at = (f32x4){0.f, 0.f, 0.f, 0.f};
#pragma unroll
                for (int kc = 0; kc < 4; ++kc) { const bf16x8 Kf = *(const LAS bf16x8*)(Ks + (16 * jt + l15) * QSTR + (32 * kc + 8 * g) * 2); at = MFMA16(Kf, Qf[kc], at); }
                if (it == jt) {
#pragma unroll
                    for (int r = 0; r < 4; ++r) if (4 * g + r > l15) at[r] = 0.f; }
                const unsigned lo = pk2(at[0], at[1]), hi = pk2(at[2], at[3]);
                if (jt & 1) { pf[it][jt >> 1].z = lo; pf[it][jt >> 1].w = hi; } else { pf[it][jt >> 1].x = lo; pf[it][jt >> 1].y = hi; } }
            asm volatile("" ::: "memory"); }
        f32x4 acc[4][2];
#pragma unroll
        for (int it = 0; it < 4; ++it) { acc[it][0] = (f32x4){0.f, 0.f, 0.f, 0.f}; acc[it][1] = (f32x4){0.f, 0.f, 0.f, 0.f}; }
#pragma unroll
        for (int s = 0; s < 2; ++s)
#pragma unroll
            for (int nt = 0; nt < 2; ++nt) { const LAS unsigned char* p = Vs + (32 * s + 4 * g + (l15 >> 2)) * VSTR + (32 * w + 16 * nt + 4 * (l15 & 3)) * 2;
                const s16x4 lo = tr16(p), hi = tr16(p + 16 * VSTR); const bf16x8 vf = (bf16x8){lo[0], lo[1], lo[2], lo[3], hi[0], hi[1], hi[2], hi[3]};
#pragma unroll
                for (int it = 0; it < 4; ++it) acc[it][nt] = MFMA16(vf, __builtin_bit_cast(bf16x8, pf[it][s]), acc[it][nt]); }
#pragma unroll
        for (int it = 0; it < 4; ++it) { bf16x8 Qf[4];
#pragma unroll
            for (int kc = 0; kc < 4; ++kc) Qf[kc] = *(const LAS bf16x8*)(Qs + (16 * it + l15) * QSTR + (32 * kc + 8 * g) * 2);
#pragma unroll
            for (int kc = 0; kc < 4; ++kc)
#pragma unroll
                for (int nt = 0; nt < 2; ++nt) acc[it][nt] = MFMA16(Sf[kc][nt], Qf[kc], acc[it][nt]);
            asm volatile("" ::: "memory"); }
#pragma unroll
        for (int it = 0; it < 4; ++it) { float s = 0.f;
#pragma unroll
            for (int nt = 0; nt < 2; ++nt) s += (acc[it][nt][0] * acc[it][nt][0] + acc[it][nt][1] * acc[it][nt][1]) + (acc[it][nt][2] * acc[it][nt][2] + acc[it][nt][3] * acc[it][nt][3]);
            s += __shfl_xor(s, 16); s += __shfl_xor(s, 32);
            if (g == 0) ssqx[(16 * it + l15) * 8 + w] = s; }
        __syncthreads();
        char* yb = (char*)((bf16*)(a.ws + WS_Y0) + row0 * 1024 + h * 256 + 32 * w); const unsigned yo = (unsigned)l15 * 2048 + (unsigned)g * 8;
#pragma unroll
        for (int it = 0; it < 4; ++it) { const LAS f32x4* sp = (const LAS f32x4*)(ssqx + (16 * it + l15) * 8); const f32x4 s0 = sp[0], s1 = sp[1];
            const float rstd = frsq(((s0[0] + s0[1]) + (s0[2] + s0[3]) + (s1[0] + s1[1]) + (s1[2] + s1[3])) * (1.0f / 256.0f) + EPS);
#pragma unroll
            for (int nt = 0; nt < 2; ++nt) { const float r0 = bflo(rv[it][nt].x), r1 = bfhi(rv[it][nt].x), r2 = bflo(rv[it][nt].y), r3 = bfhi(rv[it][nt].y);
                const f32x4 o = acc[it][nt] * rstd * gon[nt];
                v2u y; y.x = pk2(o[0] * (r0 * frcp(1.0f + fexp(-r0))), o[1] * (r1 * frcp(1.0f + fexp(-r1)))); y.y = pk2(o[2] * (r2 * frcp(1.0f + fexp(-r2))), o[3] * (r3 * frcp(1.0f + fexp(-r3))));
                *(v2u*)(yb + (size_t)(16 * it) * 2048 + nt * 32 + yo) = y; } }
        __syncthreads();
    }
}

template <int MODE  >
__device__ __forceinline__ void thin_gemm16(Frame& F, const bf16* A, const bf16* Wt, const float* rs, const float* bfg, void* out) {
    const int l15 = F.lane & 15, g = F.lane >> 4;
    for (int blk = F.vcu * NWAVES + F.wave; blk < M / 16; blk += F.G * NWAVES) {
        const char* ab = (const char*)(A + (size_t)blk * 16 * D); const unsigned ao = (unsigned)l15 * (D * 2) + (unsigned)g * 16;
        const char* wb = (const char*)Wt;
        f32x4 acc = (f32x4){0.f, 0.f, 0.f, 0.f};
#pragma unroll
        for (int kb = 0; kb < 2; ++kb) { bf16x8 af[16], wf[16];
#pragma unroll
            for (int s = 0; s < 16; ++s) { af[s] = *(const bf16x8*)(ab + (kb * 16 + s) * 64 + ao); wf[s] = *(const bf16x8*)(wb + (kb * 16 + s) * 64 + ao); }
#pragma unroll
            for (int s = 0; s < 16; ++s) acc = MFMA16(af[s], wf[s], acc);
            asm volatile("" ::: "memory"); }
        float rv[4];
#pragma unroll
        for (int r = 0; r < 4; ++r) rv[r] = rs[blk * 16 + 4 * g + r];
        const float bb = MODE == 1 ? bfg[l15] : 0.f;
#pragma unroll
        for (int r = 0; r < 4; ++r) { const int row = blk * 16 + 4 * g + r;
            if (MODE == 0) { ((bf16*)out)[(size_t)row * 16 + l15] = (bf16)f2bf(acc[r] * rv[r]); }
            else { const float z = acc[r] * (frsq(rv[r] * (1.0f / D) + EPS)) + bb; ((float*)out)[(size_t)row * 16 + l15] = log_sigmoid(z) * LOG2E; } }
    }
}
__device__ __forceinline__ void fox_cumsum(Frame& F, const Args& a) {
    const float* LF = (const float*)(a.ws + WS_LF); float* CB = (float*)(a.ws + WS_CB); LAS double* wt = (LAS double*)F.lds;
    for (int item = F.vcu; item < BATCH * 16 * 4; item += F.G) { const int bh = item >> 2, q = item & 3, b = bh >> 4, h = bh & 15;
        const float* src = LF + (size_t)b * SEQ * 16 + h;
        double carry = 0.0;
        { float cv[12];
#pragma unroll
          for (int j = 0; j < 12; ++j) { const int p = F.tid + 512 * j; cv[j] = src[(size_t)(p < 2048 * q ? p : 0) * 16]; }
#pragma unroll
          for (int j = 0; j < 12; ++j) carry += (F.tid + 512 * j < 2048 * q) ? (double)cv[j] : 0.0; }
#pragma unroll
        for (int o = 1; o < 64; o <<= 1) carry += __shfl_xor(carry, o);
        double loc[4]; double run = 0.0; const int p0 = 2048 * q + 4 * F.tid;
#pragma unroll
        for (int e = 0; e < 4; ++e) { run += (double)src[(size_t)(p0 + e) * 16]; loc[e] = run; }
        double inc = run;
#pragma unroll
        for (int o = 1; o < 64; o <<= 1) { const double v = __shfl_up(inc, o); if (F.lane >= o) inc += v; }
        if (F.lane == 63) { wt[F.wave] = inc; wt[8 + F.wave] = carry; }
        __syncthreads();
        double off = inc - run;
        for (int w = 0; w < NWAVES; ++w) { off += wt[8 + w]; if (w < F.wave) off += wt[w]; }
#pragma unroll
        for (int e = 0; e < 4; ++e) CB[(size_t)bh * SEQ + p0 + e] = (float)(off + loc[e]);
        __syncthreads();
    }
}
__device__ __forceinline__ void final_norm(Frame& F, const Args& a) {
    const int gw = F.vcu * NWAVES + F.wave, NGW = F.G * NWAVES; const float* ssq = (const float*)(a.ws + WS_SSQ) + 3 * M; const float* gf = a.in[19]; const bf16* XB = (const bf16*)(a.ws + WS_XB);
    f32x4 gv[4];
#pragma unroll
    for (int j = 0; j < 4; ++j) gv[j] = ((const f32x4*)gf)[F.lane + 64 * j];
    int m = 2 * gw; v2u v[8]; float q0 = 0.f, q1 = 0.f;
    if (m < M) { const v2u* xr = (const v2u*)(XB + (size_t)m * D) + F.lane;
#pragma unroll
        for (int j = 0; j < 8; ++j) v[j] = xr[64 * j];
        q0 = ssq[m]; q1 = ssq[m + 1]; }
#pragma unroll 1
    for (; m < M; m += 2 * NGW) { const int mn = m + 2 * NGW; v2u w[8]; float n0 = 0.f, n1 = 0.f;
        if (mn < M) { const v2u* xn = (const v2u*)(XB + (size_t)mn * D) + F.lane;
#pragma unroll
            for (int j = 0; j < 8; ++j) w[j] = xn[64 * j];
            n0 = ssq[mn]; n1 = ssq[mn + 1]; }
        const float rs0 = frsq(q0 * (1.0f / D) + EPS), rs1 = frsq(q1 * (1.0f / D) + EPS);
        f32x4* xo = (f32x4*)(a.out + (size_t)m * D) + F.lane;
#pragma unroll
        for (int j = 0; j < 8; ++j) { const f32x4 x = (f32x4){bflo(v[j].x), bfhi(v[j].x), bflo(v[j].y), bfhi(v[j].y)}; xo[64 * j] = x * (j < 4 ? rs0 : rs1) * gv[j & 3]; }
#pragma unroll
        for (int j = 0; j < 8; ++j) v[j] = w[j];
        q0 = n0; q1 = n1; }
}

typedef __attribute__((address_space(1))) unsigned gu32;
#define RLX_AGENT __ATOMIC_RELAXED, __HIP_MEMORY_SCOPE_AGENT
#define XB_TMO      128
#define XB_XCNT(j)  (256  + 64 * (j))
#define XB_XSUB(j)  (1280 + 64 * (j))
#define XB_XGEN(j)  (2304 + 64 * (j))
#define XB_TOP      3328
#define XB_TOPGEN   3392
#define XCD_BAR_WORDS 3456
#define XB_SPIN_CAP (1u << 18)

__device__ __forceinline__ unsigned xb_ld(unsigned* p)              { return __hip_atomic_load(p, __ATOMIC_RELAXED, __HIP_MEMORY_SCOPE_AGENT); }
__device__ __forceinline__ unsigned xb_add(unsigned* p, unsigned v) { return __hip_atomic_fetch_add(p, v, __ATOMIC_RELAXED, __HIP_MEMORY_SCOPE_AGENT); }
__device__ __forceinline__ unsigned xb_xcc_id() { return (unsigned)__builtin_amdgcn_s_getreg((3 << 11) | 20) & 0xFu; }
#define XB_SPIN(cond, bar) do { unsigned _sp = 0; while (cond) { __builtin_amdgcn_s_sleep(1); \
    if ((++_sp & 255u) == 0u) { if (xb_ld(&(bar)[XB_TMO])) break; if (_sp > XB_SPIN_CAP) { atomicAdd(&(bar)[XB_TMO], 1u); break; } } } } while (0)

struct XcdBarrier {
    unsigned* bar; unsigned x;
    volatile LAS unsigned* st;
};

__device__ __forceinline__ XcdBarrier xcd_barrier_post(unsigned* bar, volatile LAS unsigned* st) {
    XcdBarrier b; b.bar = bar; b.x = xb_xcc_id(); b.st = st;
    if (mk_tid() == 0) (void)xb_add(&bar[XB_XCNT(b.x)], 1u);
    return b;
}
__device__ __forceinline__ void xcd_barrier_complete(unsigned* bar, unsigned x, unsigned& nloc, unsigned& nx) {
    const unsigned G = gridDim.x * gridDim.y * gridDim.z;
    unsigned sum, cnt, mine, sp = 0u;
    for (;;) {
        sum = 0u; cnt = 0u; mine = 0u;
#pragma unroll
        for (unsigned j = 0; j < 16; ++j) { const unsigned c = xb_ld(&bar[XB_XCNT(j)]); sum += c; cnt += (c > 0u) ? 1u : 0u; mine = (j == x) ? c : mine; }
        if (sum == G) break;
        __builtin_amdgcn_s_sleep(1);
        if ((++sp & 255u) == 0u) { if (xb_ld(&bar[XB_TMO])) break; if (sp > XB_SPIN_CAP) { atomicAdd(&bar[XB_TMO], 1u); break; } }
    }
    nloc = mine > 0u ? mine : 1u; nx = cnt > 0u ? cnt : 1u;
}

__device__ __forceinline__ void xcd_barrier(const XcdBarrier& b) {
    asm volatile("s_waitcnt vmcnt(0)" ::: "memory");
    __syncthreads();
    if (mk_tid() == 0) {
        unsigned* bar = b.bar;
        __builtin_amdgcn_s_waitcnt(0);
        unsigned nloc = b.st[0], nx = b.st[1];
        if (nloc == 0u) { xcd_barrier_complete(bar, b.x, nloc, nx); b.st[0] = nloc; b.st[1] = nx; }
        const unsigned old = xb_add(&bar[XB_XSUB(b.x)], 1u);
        const unsigned gen = old / nloc;
        if (old + 1u == (gen + 1u) * nloc) {
            __builtin_amdgcn_fence(__ATOMIC_RELEASE, "agent");
            asm volatile("s_waitcnt vmcnt(0)" ::: "memory");
            const unsigned og = xb_add(&bar[XB_TOP], 1u);
            const unsigned tg = og / nx;
            if (og + 1u == (tg + 1u) * nx) xb_add(&bar[XB_TOPGEN], 1u);
            else XB_SPIN(xb_ld(&bar[XB_TOPGEN]) == tg, bar);
            __builtin_amdgcn_fence(__ATOMIC_ACQUIRE, "agent");
            xb_add(&bar[XB_XGEN(b.x)], 1u);
            asm volatile("s_waitcnt vmcnt(0)" ::: "memory");
        } else {
            XB_SPIN(xb_ld(&bar[XB_XGEN(b.x)]) == gen, bar);
            __builtin_amdgcn_fence(__ATOMIC_ACQUIRE, "agent");
            asm volatile("s_waitcnt vmcnt(0)" ::: "memory");
        }
    }
    __syncthreads();
}

constexpr int MISC_OFF = RING_BYTES + 320;
constexpr size_t WS_BAR = 65536;
#ifndef MK_MULTI
#define MK_MULTI 0
#endif
constexpr int N_PHASES = 15;
__device__ __forceinline__ Args load_args() {
    const __attribute__((address_space(4))) Args* p = (const __attribute__((address_space(4))) Args*)__builtin_amdgcn_kernarg_segment_ptr(); asm volatile("" : "+s"(p)); const Args* g = (const Args*)p; return *g; }
__global__ void __launch_bounds__(NWAVES * 64, 2) mk_fwd(Args args_) {
    extern __shared__ __attribute__((aligned(16))) unsigned char lds[];
    Frame F; F.lds = (LAS unsigned char*)lds;
    { const int t0_ = threadIdx.x; const unsigned hw = __builtin_amdgcn_s_getreg(4 | ((6 - 1) << 11)) & 63u; if ((t0_ & 63) == 0) ((LAS int*)(F.lds + RING_BYTES))[hw] = t0_ >> 6; }
    __syncthreads();
    F.tid = mk_tid(); F.lane = F.tid & 63; F.wave = __builtin_amdgcn_readfirstlane(F.tid >> 6);
    F.G = gridDim.x; { const int bx = blockIdx.x; F.vcu = (F.G % 8 == 0) ? (bx % 8) * (F.G / 8) + bx / 8 : bx; }
    const int lo = MK_MULTI ? args_.ph_lo : 0, hi = MK_MULTI ? args_.ph_hi : N_PHASES;
    if (F.tid < 32) ((LAS unsigned*)(F.lds + MISC_OFF))[F.tid] = 0u;
    __syncthreads();
    XcdBarrier bar; bar.bar = nullptr; bar.x = 0; bar.st = nullptr;
    if (!MK_MULTI) bar = xcd_barrier_post((unsigned*)(args_.ws + WS_BAR), (volatile LAS unsigned*)(F.lds + MISC_OFF) + 8);
    if (args_.ph_hi == 0x7fffffff) cg::this_grid().sync();
#ifndef PH_MASK
#define PH_MASK 0x7fff
#endif
#define IN(k) (((PH_MASK >> (k)) & 1) && lo <= (k) && (k) < hi)
#define SEAM(k) do { if (IN(k) && IN((k) + 1)) { xcd_barrier(bar); } { int t_ = mk_tid(); asm volatile("" : "+v"(t_)); F.tid = t_; F.lane = t_ & 63; F.wave = __builtin_amdgcn_readfirstlane(t_ >> 6); } } while (0)
#define PH_ARGS() const Args args = load_args(); unsigned char* ws = args.ws; bf16* XB = (bf16*)(ws + WS_XB); float* ssq = (float*)(ws + WS_SSQ); (void)XB; (void)ssq
    if (IN(0)) { PH_ARGS(); if (MK_MULTI && blockIdx.x == 0) { unsigned* bw = (unsigned*)(ws + WS_BAR); for (int i = F.tid; i < 4096 + 64; i += NWAVES * 64) bw[i] = 0u; } p0_prologue(F, args); } SEAM(0);
    if (IN(1)) { PH_ARGS(); thin_gemm16<0>(F, XB, (const bf16*)(ws + WS_WG0), (const float*)(ws + WS_RSTD0), nullptr, ws + WS_GLB); __syncthreads();
        pg8::Gemm g{XB, (const bf16*)(ws + WS_WIN0), M, N0P, D}; pg8::StaticOrder S; S.init(M, N0P, F.G, (int)blockIdx.x);
        pg8::EpiScaleBf16<0, 0> E{(bf16*)(ws + WS_PROJ0), N0P, (const float*)(ws + WS_RSTD0)};
        pg8::gemm_phase<pg8::EpiScaleBf16<0, 0>, pg8::StaticOrder, true, true>(F.lds, g, S, E); } SEAM(1);
    if (IN(2)) { PH_ARGS(); gla_pass_a(F, args); } SEAM(2);
    if (IN(3)) { PH_ARGS(); gla_scan(F, args); } SEAM(3);
    if (IN(4)) { PH_ARGS(); gla_pass_c(F, args); } SEAM(4);
    if (IN(5)) { PH_ARGS(); pg8::Gemm g{(const bf16*)(ws + WS_Y0), (const bf16*)(ws + WS_WOUT0), M, D, D}; pg8::StaticOrder S; S.init(M, D, F.G, (int)blockIdx.x);
        typedef pg8::EpiRes<true, false, true> ER; ER E{nullptr, XB, nullptr, XB, ssq};
        pg8::gemm_phase<ER, pg8::StaticOrder, true, true>(F.lds, g, S, E); } SEAM(5);
    if (IN(6)) { PH_ARGS(); pg8::Gemm g{XB, (const bf16*)(ws + WS_W1A), M, FF, D}; pg8::StaticOrder S; S.init(M, FF, F.G, (int)blockIdx.x);
        pg8::EpiScaleBf16<1, 1> E{(bf16*)(ws + WS_U), FF, ssq};
        pg8::gemm_phase<pg8::EpiScaleBf16<1, 1>, pg8::StaticOrder, true, true>(F.lds, g, S, E); } SEAM(6);
    if (IN(7)) { PH_ARGS(); pg8::Gemm g{(const bf16*)(ws + WS_U), (const bf16*)(ws + WS_W2A), M, D, FF}; pg8::StaticOrder S; S.init(M, D, F.G, (int)blockIdx.x);
        typedef pg8::EpiRes<true, false, true> ER; ER E{nullptr, XB, nullptr, XB, ssq + M};
        pg8::gemm_phase<ER, pg8::StaticOrder, true, true>(F.lds, g, S, E); } SEAM(7);
    if (IN(8)) { PH_ARGS(); thin_gemm16<1>(F, XB, (const bf16*)(ws + WS_WF1), ssq + M, args.in[12], ws + WS_LF); __syncthreads();
        pg8::Gemm g{XB, (const bf16*)(ws + WS_WIN1), M, N1P, D}; pg8::StaticOrder S; S.init(M, N1P, F.G, (int)blockIdx.x);
        pg8::EpiFox E{(bf16*)(ws + WS_Q), (bf16*)(ws + WS_K), (bf16*)(ws + WS_V), (bf16*)(ws + WS_G), (float*)(ws + WS_LF), ssq + M, args.in[13], args.in[14], args.in[12], attn_body::C2, (unsigned*)(ws + WS_BAR) + 4096 + 128};
        pg8::gemm_phase<pg8::EpiFox, pg8::StaticOrder, true, true>(F.lds, g, S, E); } SEAM(8);
    if (IN(9)) { PH_ARGS(); fox_cumsum(F, args); } SEAM(9);
    if (IN(10)) { PH_ARGS(); const attn_body::AttnTensors AT{(const attn_body::bf16*)(ws + WS_Q), (const attn_body::bf16*)(ws + WS_K), (const attn_body::bf16*)(ws + WS_V), (const attn_body::bf16*)(ws + WS_G),
                                               (const float*)(ws + WS_CB), args.in[13], args.in[14], (attn_body::bf16*)(ws + WS_O), (unsigned*)(ws + WS_BAR) + 4096, (const unsigned*)(ws + WS_BAR) + 4096 + 128};
        const attn_body::StaticOrder S((int)F.G, (int)blockIdx.x);
        attn_body::attn_phase<attn_body::StaticOrder>((char*)lds, AT, S); } SEAM(10);
    if (IN(11)) { PH_ARGS(); pg8::Gemm g{(const bf16*)(ws + WS_O), (const bf16*)(ws + WS_WOUT1), M, D, D}; pg8::StaticOrder S; S.init(M, D, F.G, (int)blockIdx.x);
        typedef pg8::EpiRes<true, false, true> ER; ER E{nullptr, XB, nullptr, XB, ssq + 2 * M};
        pg8::gemm_phase<ER, pg8::StaticOrder, true, true>(F.lds, g, S, E); } SEAM(11);
    if (IN(12)) { PH_ARGS(); pg8::Gemm g{XB, (const bf16*)(ws + WS_W1B), M, FF, D}; pg8::StaticOrder S; S.init(M, FF, F.G, (int)blockIdx.x);
        pg8::EpiScaleBf16<1, 1> E{(bf16*)(ws + WS_U), FF, ssq + 2 * M};
        pg8::gemm_phase<pg8::EpiScaleBf16<1, 1>, pg8::StaticOrder, true, true>(F.lds, g, S, E); } SEAM(12);
    if (IN(13)) { PH_ARGS(); pg8::Gemm g{(const bf16*)(ws + WS_U), (const bf16*)(ws + WS_W2B), M, D, FF}; pg8::StaticOrder S; S.init(M, D, F.G, (int)blockIdx.x);
        typedef pg8::EpiRes<true, false, true> ER; ER E{nullptr, XB, nullptr, XB, ssq + 3 * M};
        pg8::gemm_phase<ER, pg8::StaticOrder, true, true>(F.lds, g, S, E); } SEAM(13);
    if (IN(14)) { PH_ARGS(); final_norm(F, args); }
#undef IN
#undef SEAM
}

extern "C" void kernel_launch(void* const* d_in, const int* in_sizes, int n_in, void* d_out, int out_size, void* d_ws, size_t ws_size, hipStream_t stream) {
    static int grid = 0;
    if (grid == 0) {
        if (n_in != 20 || in_sizes[0] != M * D || out_size != M * D || ws_size < WS_END) { fprintf(stderr, "kernel_launch: unexpected shapes (n_in %d, in0 %d, out %d, ws %zu); nothing launched\n", n_in, n_in > 0 ? in_sizes[0] : -1, out_size, ws_size); grid = -1; return; }
        int dev = 0, cus = 0, per_cu = 0;
        if (hipGetDevice(&dev) != hipSuccess || hipDeviceGetAttribute(&cus, hipDeviceAttributeMultiprocessorCount, dev) != hipSuccess) { grid = -1; return; }
        if (hipFuncSetAttribute((const void*)mk_fwd, hipFuncAttributeMaxDynamicSharedMemorySize, LDS_BYTES) != hipSuccess) { fprintf(stderr, "kernel_launch: hipFuncSetAttribute failed\n"); grid = -1; return; }
        if (hipOccupancyMaxActiveBlocksPerMultiprocessor(&per_cu, (const void*)mk_fwd, NWAVES * 64, LDS_BYTES) != hipSuccess || per_cu < 1) { fprintf(stderr, "kernel_launch: occupancy query says %d blocks per CU\n", per_cu); per_cu = 1; }
        (void)hipGetLastError();
        grid = cus;
        if (grid != 256) fprintf(stderr, "kernel_launch: note: %d CUs (the attention order is balanced for 256)\n", grid);
    }
    if (grid < 0) return;
    Args a{};
    for (int i = 0; i < 20; ++i) a.in[i] = (const float*)d_in[i];
    a.out = (float*)d_out; a.ws = (unsigned char*)d_ws;
#if MK_MULTI
    for (int p = 0; p < N_PHASES; ++p) { a.ph_lo = p; a.ph_hi = p + 1; hipLaunchKernelGGL(mk_fwd, dim3(grid), dim3(NWAVES * 64), LDS_BYTES, stream, a); }
#else
    a.ph_lo = 0; a.ph_hi = N_PHASES;
    if (hipMemsetAsync((char*)d_ws + WS_BAR, 0, (4096 + 64) * 4, stream) != hipSuccess) { fprintf(stderr, "kernel_launch: hipMemsetAsync of the barrier / queue words failed; nothing launched\n"); return; }
    void* kargs[] = {&a};
    const hipError_t e = hipLaunchCooperativeKernel((const void*)mk_fwd, dim3(grid), dim3(NWAVES * 64), kargs, LDS_BYTES, stream);
    if (e != hipSuccess) fprintf(stderr, "kernel_launch: cooperative launch failed: %s (grid %d)\n", hipGetErrorString(e), grid);
#endif
}
```

```cpp
#include <hip/hip_runtime.h>
#include <hip/hip_cooperative_groups.h>
#include <hip/hip_bf16.h>
#include <cstdio>
#include <cstdint>
#include <cmath>
namespace cg = cooperative_groups;
__device__ __forceinline__ int mk_tid() {
    const unsigned hw = __builtin_amdgcn_s_getreg(4 | ((6 - 1) << 11)) & 63u;
    const int wave = *(const volatile __attribute__((address_space(3))) int*)(unsigned)(131072u + 4u * hw);
    int lane; asm volatile("v_mbcnt_lo_u32_b32 %0, -1, 0\n\tv_mbcnt_hi_u32_b32 %0, -1, %0" : "=v"(lane));
    return __builtin_amdgcn_readfirstlane(wave) * 64 + lane;
}
namespace pg8 {
#define PG8_LAS __attribute__((address_space(3)))
typedef unsigned short bf16_t;
typedef short bf16x8 __attribute__((ext_vector_type(8)));
typedef float f32x4 __attribute__((ext_vector_type(4)));
typedef unsigned u32x4 __attribute__((ext_vector_type(4)));
constexpr int BM = 256, BK = 64, HALF = 128, HTB = HALF * BK * 2  , STAGE_BYTES = 8 * HTB, NXCD = 8, WGM = 8;

__host__ __device__ __forceinline__ int lds_byte(int r, int c) { const int st = (r >> 4) * 2 + (c >> 5), rr = r & 15, cc = c & 31, ob = rr * 64 + cc * 2; return st * 1024 + (ob ^ (((ob >> 9) & 1) << 5)); }
__host__ __device__ __forceinline__ void stage_rc(int b, int& R, int& C) { const int st = b / 1024, sb = b % 1024, swz = sb ^ (((sb >> 9) & 1) << 5); R = (st >> 1) * 16 + swz / 64; C = (st & 1) * 32 + (swz % 64) / 2; }
__host__ __device__ __forceinline__ int perm32(int rho) { const int n = rho >> 4, i = rho & 15; return 8 * (i >> 2) + 4 * n + (i & 3); }

struct Unit { int pm, pn; };
struct Gemm { const bf16_t* A; const bf16_t* Bt; int M, N, K; };

struct StaticOrder {
    int nM, nN, nwg, G, c;
    __host__ __device__ void init(int M, int N, int G_, int c_) { nM = M / BM; nN = N / BM; nwg = nM * nN; G = G_; c = c_; }
    __host__ __device__ bool next(int i, Unit& u) const {
        const long L = (long)i * G + c; if (L >= nwg) return false;
        int wgid = (int)L; { const int q = nwg / NXCD, r = nwg % NXCD, xcd = wgid % NXCD, off = wgid / NXCD; wgid = (xcd < r ? xcd * (q + 1) : r * (q + 1) + (xcd - r) * q) + off; }
        const int nig = WGM * nN, gid = wgid / nig, fm = gid * WGM, gsz = (nM - fm) < WGM ? (nM - fm) : WGM;
        u.pm = fm + ((wgid % nig) % gsz); u.pn = (wgid % nig) / gsz; return true;
    }
    __device__ __forceinline__ void a_ready(const Unit&) const {}
    __device__ __forceinline__ void done(const Unit&) const {}
};

__device__ __forceinline__ unsigned cvt_pk_bf16(float lo, float hi) { unsigned r; asm volatile("v_cvt_pk_bf16_f32 %0, %1, %2" : "=v"(r) : "v"(lo), "v"(hi)); return r; }
constexpr float EPS_ = 1e-6f;
template <int ACT  , int RSMODE  > struct EpiScaleBf16 {
    static constexpr bool PERM = true, AFTER_DRAIN = false;
    bf16_t* O; int ldc; const float* rs;
    __device__ __forceinline__ void pre(const Unit& u, int wr, int fr, float (&p)[8]) const { const int row0 = u.pm * BM + wr * 64 + fr;
#pragma unroll
        for (int i = 0; i < 8; ++i) p[i] = rs[row0 + (i >> 2) * HALF + (i & 3) * 16]; }
    __device__ __forceinline__ void operator()(const f32x4 (&acc)[2][2][4][2], const Unit& u, int wr, int wc, int fr, int fq, const float (&p)[8]) const {
        const int row0 = u.pm * BM + wr * 64 + fr, col0 = u.pn * BM + wc * 64 + 8 * fq;
        float sv[2][4];
#pragma unroll
        for (int i = 0; i < 8; ++i) sv[i >> 2][i & 3] = p[i];
#pragma unroll
        for (int ai = 0; ai < 2; ++ai)
#pragma unroll
            for (int m = 0; m < 4; ++m) { const int row = row0 + ai * HALF + m * 16; float s = sv[ai][m]; if (RSMODE == 1) s = __builtin_amdgcn_rsqf(s * (1.0f / 1024.0f) + EPS_);
                bf16_t* rowp = O + (size_t)row * ldc + col0;
#pragma unroll
                for (int bj = 0; bj < 2; ++bj) { f32x4 v0 = acc[ai][bj][m][0] * s, v1 = acc[ai][bj][m][1] * s;
                    if (ACT == 1) {
#pragma unroll
                        for (int i = 0; i < 4; ++i) { const float a = fmaxf(v0[i], 0.f), b = fmaxf(v1[i], 0.f); v0[i] = a * a; v1[i] = b * b; } }
                    u32x4 w; w.x = cvt_pk_bf16(v0[0], v0[1]); w.y = cvt_pk_bf16(v0[2], v0[3]); w.z = cvt_pk_bf16(v1[0], v1[1]); w.w = cvt_pk_bf16(v1[2], v1[3]);
                    *(u32x4*)(rowp + bj * 32) = w; } }
    }
};
template <bool BASE_BF16, bool OUT_F32, bool OUT_BF16> struct EpiRes {
    static constexpr bool PERM = false, AFTER_DRAIN = false;
    const float* base32; const bf16_t* base16; float* out; bf16_t* ob; float* ssq;
    __device__ __forceinline__ void pre(const Unit&, int, int, float (&p)[8]) const {
#pragma unroll
        for (int i = 0; i < 8; ++i) p[i] = 0.f; }
    __device__ __forceinline__ void operator()(const f32x4 (&acc)[2][2][4][2], const Unit& u, int wr, int wc, int fr, int fq, const float (&)[8]) const {
        typedef unsigned u32x2v __attribute__((ext_vector_type(2)));
        const int row0 = u.pm * BM + wr * 64 + fr, col0 = u.pn * BM + wc * 64 + 4 * fq;
#pragma unroll
        for (int ai = 0; ai < 2; ++ai) {
            f32x4 bv[4][2][2];
#pragma unroll
            for (int m = 0; m < 4; ++m)
#pragma unroll
                for (int bj = 0; bj < 2; ++bj)
#pragma unroll
                    for (int n = 0; n < 2; ++n) { const size_t o = (size_t)(row0 + ai * HALF + m * 16) * 1024 + col0 + bj * 32 + n * 16;
                        if (BASE_BF16) { const u32x2v w = *(const u32x2v*)(base16 + o); bv[m][bj][n] = (f32x4){__uint_as_float(w.x << 16), __uint_as_float(w.x & 0xffff0000u), __uint_as_float(w.y << 16), __uint_as_float(w.y & 0xffff0000u)}; }
                        else bv[m][bj][n] = *(const f32x4*)(base32 + o); }
#pragma unroll
            for (int m = 0; m < 4; ++m) { const int row = row0 + ai * HALF + m * 16; const size_t off = (size_t)row * 1024 + col0; float s = 0.f;
#pragma unroll
                for (int bj = 0; bj < 2; ++bj)
#pragma unroll
                    for (int n = 0; n < 2; ++n) { const size_t o = off + bj * 32 + n * 16; const f32x4 v = acc[ai][bj][m][n] + bv[m][bj][n];
                        if (OUT_F32) *(f32x4*)(out + o) = v;
                        s += (v[0] * v[0] + v[1] * v[1]) + (v[2] * v[2] + v[3] * v[3]);
                        if (OUT_BF16) { u32x2v w; w.x = cvt_pk_bf16(v[0], v[1]); w.y = cvt_pk_bf16(v[2], v[3]); *(u32x2v*)(ob + o) = w; } }
                s += __shfl_xor(s, 16); s += __shfl_xor(s, 32);
                if (fq == 0) atomicAdd(ssq + row, s); }
            asm volatile("" ::: "memory"); }
    }
};
struct EpiFox {
    static constexpr bool PERM = true, AFTER_DRAIN = false;
    bf16_t* Q; bf16_t* K; bf16_t* V; bf16_t* G; float* LF; const float* ssq; const float* gq; const float* gk; const float* bfg; float qscale; unsigned* nrm;
    __device__ __forceinline__ void pre(const Unit& u, int wr, int fr, float (&p)[8]) const { const int row0 = u.pm * BM + wr * 64 + fr;
#pragma unroll
        for (int i = 0; i < 8; ++i) p[i] = ssq[row0 + (i >> 2) * HALF + (i & 3) * 16]; }
    __device__ __forceinline__ void operator()(const f32x4 (&acc)[2][2][4][2], const Unit& u, int wr, int wc, int fr, int fq, const float (&p)[8]) const {
        const int kind = u.pn >> 2; const int row0 = u.pm * BM + wr * 64 + fr, col0 = (u.pn & 3) * BM + wc * 64 + 8 * fq;
        f32x4 gv[2][2]; const float* gsel = kind == 0 ? gq : gk; const float gsc = kind == 0 ? qscale : 1.0f;
#pragma unroll
        for (int bj = 0; bj < 2; ++bj)
#pragma unroll
            for (int n = 0; n < 2; ++n) gv[bj][n] = *(const f32x4*)(gsel + bj * 32 + 8 * fq + 4 * n) * gsc;
        bf16_t* dst = kind == 0 ? Q : kind == 1 ? K : kind == 2 ? V : G;
        float sq[2][4]; float nmax = 0.f;
#pragma unroll
        for (int i = 0; i < 8; ++i) sq[i >> 2][i & 3] = p[i];
#pragma unroll
        for (int ai = 0; ai < 2; ++ai)
#pragma unroll
            for (int m = 0; m < 4; ++m) { const int row = row0 + ai * HALF + m * 16; const float rs = __builtin_amdgcn_rsqf(sq[ai][m] * (1.0f / 1024.0f) + EPS_);
                f32x4 v[2][2];
#pragma unroll
                for (int bj = 0; bj < 2; ++bj)
#pragma unroll
                    for (int n = 0; n < 2; ++n) v[bj][n] = acc[ai][bj][m][n] * rs;
                if (kind < 2) { float s = 0.f;
#pragma unroll
                    for (int bj = 0; bj < 2; ++bj)
#pragma unroll
                        for (int n = 0; n < 2; ++n) s += (v[bj][n][0] * v[bj][n][0] + v[bj][n][1] * v[bj][n][1]) + (v[bj][n][2] * v[bj][n][2] + v[bj][n][3] * v[bj][n][3]);
                    s += __shfl_xor(s, 16); s += __shfl_xor(s, 32);
                    const float hn = __builtin_amdgcn_rsqf(s * (1.0f / 64.0f) + EPS_);
#pragma unroll
                    for (int bj = 0; bj < 2; ++bj)
#pragma unroll
                        for (int n = 0; n < 2; ++n) v[bj][n] = v[bj][n] * hn * gv[bj][n];
                    float n2 = 0.f;
#pragma unroll
                    for (int bj = 0; bj < 2; ++bj)
#pragma unroll
                        for (int n = 0; n < 2; ++n) n2 += (v[bj][n][0] * v[bj][n][0] + v[bj][n][1] * v[bj][n][1]) + (v[bj][n][2] * v[bj][n][2] + v[bj][n][3] * v[bj][n][3]);
                    n2 += __shfl_xor(n2, 16); n2 += __shfl_xor(n2, 32);
                    nmax = fmaxf(nmax, n2); }
                if (kind == 3) {
#pragma unroll
                    for (int bj = 0; bj < 2; ++bj)
#pragma unroll
                        for (int n = 0; n < 2; ++n)
#pragma unroll
                            for (int i = 0; i < 4; ++i) v[bj][n][i] = __builtin_amdgcn_rcpf(1.0f + __expf(-v[bj][n][i])); }
                {
                    bf16_t* rowp = dst + (size_t)row * 1024 + col0;
#pragma unroll
                    for (int bj = 0; bj < 2; ++bj) { u32x4 w; w.x = cvt_pk_bf16(v[bj][0][0], v[bj][0][1]); w.y = cvt_pk_bf16(v[bj][0][2], v[bj][0][3]); w.z = cvt_pk_bf16(v[bj][1][0], v[bj][1][1]); w.w = cvt_pk_bf16(v[bj][1][2], v[bj][1][3]);
                        *(u32x4*)(rowp + bj * 32) = w; } }
            }
        if (kind < 2) {
            nmax = fmaxf(nmax, __shfl_xor(nmax, 1)); nmax = fmaxf(nmax, __shfl_xor(nmax, 2)); nmax = fmaxf(nmax, __shfl_xor(nmax, 4)); nmax = fmaxf(nmax, __shfl_xor(nmax, 8));
            if (fr == 0 && fq == 0) atomicMax(nrm + kind * 64 + (u.pm >> 5) * 16 + (u.pn & 3) * 4 + wc, __float_as_uint(nmax)); }
    }
};


template <class Epi, class Sched, bool ALIGN_EPI = false, bool SP2 = false>
__device__ __forceinline__ void gemm_phase(PG8_LAS unsigned char* lds, const Gemm g, const Sched& S, const Epi& E) {
    const int tid = mk_tid(), wid = __builtin_amdgcn_readfirstlane(tid >> 6), lane = tid & 63, wr = wid >> 2, wc = wid & 3, fr = lane & 15, fq = lane >> 4;
    const int K = g.K, nt = K / BK;
    unsigned voffA[2], voffB[2];
#pragma unroll
    for (int i = 0; i < 2; ++i) { int R, C; stage_rc(tid * 16 + i * 8192, R, C); const int Rb = Epi::PERM ? ((R & ~31) + perm32(R & 31)) : R;
        voffA[i] = (unsigned)(R * K + C) * 2u; voffB[i] = (unsigned)(Rb * K + C) * 2u; }
    const size_t kstep = (size_t)(BK * 2);
    const size_t hstep = (size_t)HALF * K * 2;
    const size_t tstep = 2 * hstep;
    const unsigned ldsw = (unsigned)wid * 1024u;
    const int aoff = lds_byte(wr * 64 + fr, fq * 8), boff = lds_byte(wc * 32 + fr, fq * 8);
#define PG8_SA(b, h) (((b) * 2 + (h)) * HTB)
#define PG8_SB(b, h) ((4 + (b) * 2 + (h)) * HTB)
#define PG8_STAGE(bufoff, gbase, voff) do { _Pragma("unroll") for (int _i = 0; _i < 2; ++_i) \
        __builtin_amdgcn_global_load_lds((const unsigned*)((const char*)(gbase) + (voff)[_i]), (PG8_LAS unsigned*)(lds + (bufoff) + ldsw + _i * 8192), 16, 0, 0); } while (0)
#define PG8_LDA(dst, b, h) do { _Pragma("unroll") for (int m = 0; m < 4; ++m) _Pragma("unroll") for (int k = 0; k < 2; ++k) dst[m][k] = *(const PG8_LAS bf16x8*)(lds + PG8_SA(b, h) + aoff + m * 2048 + k * 1024); } while (0)
#define PG8_LDB(dst, b, h) do { _Pragma("unroll") for (int n = 0; n < 2; ++n) _Pragma("unroll") for (int k = 0; k < 2; ++k) dst[n][k] = *(const PG8_LAS bf16x8*)(lds + PG8_SB(b, h) + boff + n * 2048 + k * 1024); } while (0)
#define PG8_MMA(ai, bj, At, Bt) do { __builtin_amdgcn_s_setprio(1); _Pragma("unroll") for (int m = 0; m < 4; ++m) _Pragma("unroll") for (int n = 0; n < 2; ++n) _Pragma("unroll") for (int k = 0; k < 2; ++k) \
        acc[ai][bj][m][n] = __builtin_amdgcn_mfma_f32_16x16x32_bf16(Bt[n][k], At[m][k], acc[ai][bj][m][n], 0, 0, 0); __builtin_amdgcn_s_setprio(0); } while (0)
#define PG8_WAIT_V(n) asm volatile("s_waitcnt vmcnt(" #n ")" ::: "memory")
#define PG8_WAIT_L(n) asm volatile("s_waitcnt lgkmcnt(" #n ")" ::: "memory")
#define PG8_BAR __builtin_amdgcn_s_barrier()
#define PG8_SCHED __builtin_amdgcn_sched_barrier(0)
    Unit cur, nxt; int ui = 0;
    if (!S.next(0, cur)) return;
    float prew[8]; E.pre(cur, wr, fr, prew);
    f32x4 acc[2][2][4][2];
#pragma unroll
    for (int a = 0; a < 2; ++a)
#pragma unroll
        for (int b = 0; b < 2; ++b)
#pragma unroll
            for (int m = 0; m < 4; ++m)
#pragma unroll
                for (int n = 0; n < 2; ++n) acc[a][b][m][n] = (f32x4){0.f, 0.f, 0.f, 0.f};
    bf16x8 At[4][2], B0[2][2], B1[2][2];
    const char* cA = (const char*)g.A + (size_t)cur.pm * tstep; const char* cB = (const char*)g.Bt + (size_t)cur.pn * tstep;
    S.a_ready(cur);
    if constexpr (SP2) {
        PG8_STAGE(PG8_SB(0, 0), cB, voffB); PG8_STAGE(PG8_SB(0, 1), cB + hstep, voffB); PG8_STAGE(PG8_SA(0, 0), cA, voffA); PG8_STAGE(PG8_SA(0, 1), cA + hstep, voffA);
        if (wr == 1) PG8_BAR;
        PG8_WAIT_V(2); PG8_BAR;
        PG8_STAGE(PG8_SB(1, 0), cB + kstep, voffB); PG8_STAGE(PG8_SA(1, 0), cA + kstep, voffA); PG8_STAGE(PG8_SB(1, 1), cB + hstep + kstep, voffB);
        PG8_WAIT_V(6); PG8_BAR;
    } else {
        PG8_STAGE(PG8_SB(0, 0), cB, voffB); PG8_STAGE(PG8_SA(0, 0), cA, voffA); PG8_STAGE(PG8_SB(0, 1), cB + hstep, voffB); PG8_STAGE(PG8_SA(0, 1), cA + hstep, voffA);
        if (wr == 1) PG8_BAR;
        PG8_WAIT_V(4); PG8_BAR;
        PG8_STAGE(PG8_SB(1, 0), cB + kstep, voffB); PG8_STAGE(PG8_SA(1, 0), cA + kstep, voffA); PG8_STAGE(PG8_SB(1, 1), cB + hstep + kstep, voffB);
        PG8_WAIT_V(6); PG8_BAR;
    }
    for (;;) {
        const bool has_next = S.next(ui + 1, nxt);
        const char* nA = has_next ? (const char*)g.A + (size_t)nxt.pm * tstep : cA; const char* nB = has_next ? (const char*)g.Bt + (size_t)nxt.pn * tstep : cB;
        for (int t = 0; t < nt; t += 2) {
            const bool last = (t == nt - 2);
            const char* a1 = cA + (size_t)(t + 1) * kstep;
            const char* a2 = last ? nA : cA + (size_t)(t + 2) * kstep; const char* b2 = last ? nB : cB + (size_t)(t + 2) * kstep;
            const char* a3 = a2 + kstep; const char* b3 = b2 + kstep;
            if (last && has_next) S.a_ready(nxt);
            if constexpr (SP2) {
            PG8_LDB(B0, 0, 0); PG8_LDB(B1, 0, 1); PG8_SCHED; PG8_LDA(At, 0, 0); PG8_STAGE(PG8_SA(1, 1), a1 + hstep, voffA);
            PG8_WAIT_V(8); PG8_WAIT_L(0); PG8_BAR; PG8_MMA(0, 0, At, B0); PG8_MMA(0, 1, At, B1); PG8_BAR; PG8_SCHED;
            PG8_LDA(At, 0, 1); PG8_STAGE(PG8_SB(0, 0), b2, voffB); PG8_STAGE(PG8_SB(0, 1), b2 + hstep, voffB); PG8_STAGE(PG8_SA(0, 0), a2, voffA);
            PG8_WAIT_V(8); PG8_WAIT_L(0); PG8_BAR; PG8_MMA(1, 0, At, B0); PG8_MMA(1, 1, At, B1); PG8_BAR; PG8_SCHED;
            PG8_LDB(B0, 1, 0); PG8_LDB(B1, 1, 1); PG8_SCHED; PG8_LDA(At, 1, 0); PG8_STAGE(PG8_SA(0, 1), a2 + hstep, voffA);
            PG8_WAIT_V(8); PG8_WAIT_L(0); PG8_BAR; PG8_MMA(0, 0, At, B0); PG8_MMA(0, 1, At, B1); PG8_BAR; PG8_SCHED;
            PG8_LDA(At, 1, 1); PG8_STAGE(PG8_SB(1, 0), b3, voffB); PG8_STAGE(PG8_SB(1, 1), b3 + hstep, voffB); PG8_STAGE(PG8_SA(1, 0), a3, voffA);
            PG8_WAIT_V(8); PG8_WAIT_L(0); PG8_BAR; PG8_MMA(1, 0, At, B0); PG8_MMA(1, 1, At, B1); PG8_BAR; PG8_SCHED;
            } else {
            PG8_LDB(B0, 0, 0); PG8_SCHED; PG8_LDA(At, 0, 0); PG8_STAGE(PG8_SA(1, 1), a1 + hstep, voffA);
            PG8_WAIT_L(8); PG8_BAR; PG8_WAIT_L(0); PG8_MMA(0, 0, At, B0); PG8_BAR; PG8_SCHED;
            PG8_LDB(B1, 0, 1); PG8_STAGE(PG8_SB(0, 0), b2, voffB);
            PG8_BAR; PG8_WAIT_L(0); PG8_MMA(0, 1, At, B1); PG8_BAR;
            PG8_LDA(At, 0, 1); PG8_STAGE(PG8_SA(0, 0), a2, voffA);
            PG8_BAR; PG8_WAIT_L(0); PG8_MMA(1, 0, At, B0); PG8_BAR; PG8_SCHED;
            PG8_STAGE(PG8_SB(0, 1), b2 + hstep, voffB);
            PG8_WAIT_V(6); PG8_BAR; PG8_MMA(1, 1, At, B1); PG8_BAR;
            PG8_LDB(B0, 1, 0); PG8_SCHED; PG8_LDA(At, 1, 0); PG8_STAGE(PG8_SA(0, 1), a2 + hstep, voffA);
            PG8_WAIT_L(8); PG8_BAR; PG8_WAIT_L(0); PG8_MMA(0, 0, At, B0); PG8_BAR; PG8_SCHED;
            PG8_LDB(B1, 1, 1); PG8_STAGE(PG8_SB(1, 0), b3, voffB);
            PG8_BAR; PG8_WAIT_L(0); PG8_MMA(0, 1, At, B1); PG8_BAR;
            PG8_LDA(At, 1, 1); PG8_STAGE(PG8_SA(1, 0), a3, voffA);
            PG8_BAR; PG8_WAIT_L(0); PG8_MMA(1, 0, At, B0); PG8_BAR; PG8_SCHED;
            PG8_STAGE(PG8_SB(1, 1), b3 + hstep, voffB);
            PG8_WAIT_V(6); PG8_BAR; PG8_MMA(1, 1, At, B1); PG8_BAR;
            }
        }
        if constexpr (ALIGN_EPI) { if (wr == 0) PG8_BAR; }
        if constexpr (!Epi::AFTER_DRAIN) { E(acc, cur, wr, wc, fr, fq, prew); S.done(cur); }
        if (!has_next) break;
#pragma unroll
        for (int a = 0; a < 2; ++a)
#pragma unroll
            for (int b = 0; b < 2; ++b)
#pragma unroll
                for (int m = 0; m < 4; ++m)
#pragma unroll
                    for (int n = 0; n < 2; ++n) acc[a][b][m][n] = (f32x4){0.f, 0.f, 0.f, 0.f};
        cur = nxt; cA = nA; cB = nB; ++ui;
        E.pre(cur, wr, fr, prew);
        if constexpr (ALIGN_EPI) { if (wr == 1) PG8_BAR; }
    }
    PG8_WAIT_V(0);
    if constexpr (!ALIGN_EPI) { if (wr == 0) PG8_BAR; }
    PG8_BAR;
    if constexpr (Epi::AFTER_DRAIN) { E.fused(acc, cur, wr, wc, fr, fq, lds, wid, lane); S.done(cur); }
#undef PG8_SA
#undef PG8_SB
#undef PG8_STAGE
#undef PG8_LDA
#undef PG8_LDB
#undef PG8_MMA
#undef PG8_WAIT_V
#undef PG8_WAIT_L
#undef PG8_BAR
#undef PG8_SCHED
}
}
#include <hip/hip_bf16.h>
#include <cmath>
namespace attn_body {
using bf16=__hip_bfloat16;
using bf16x8=__attribute__((ext_vector_type(8)))short;
using s16x4=__attribute__((ext_vector_type(4)))short;
using f32x16=__attribute__((ext_vector_type(16)))float;
using u32x4=__attribute__((ext_vector_type(4)))unsigned;
using f32x4_t=__attribute__((ext_vector_type(4)))float;
constexpr int BATCH=4,NHEAD=16,SEQ=8192,D=64,DM=NHEAD*D;
constexpr int NW=8,QBLK=32,QB=QBLK*NW,KVBLK=64,NQB=SEQ/QB;
constexpr int ATTN_PITCH=DM, ATTN_UNIT_ROWS=QB;
__device__ __forceinline__ int crow(int r,int hi){return (r&3)+8*(r>>2)+4*hi;}
#define SBAR() __builtin_amdgcn_sched_barrier(0)
__device__ __forceinline__ void cmask(f32x16&p0,f32x16&p1,int jb,int qrel,int hi){
  const float NEG=-INFINITY; int kb=64*jb+4*hi;
  #pragma unroll
  for(int r=0;r<16;++r){int kv=kb+(r&3)+8*(r>>2); if(kv>qrel)p0[r]=NEG; if(kv+32>qrel)p1[r]=NEG;}
}

constexpr int NSLOT=3, SLOTB=8192;
constexpr int LDS_K=0, LDS_V=NSLOT*SLOTB, LDS_WS=2*NSLOT*SLOTB, LDS_OST=LDS_WS+NW*64*4, LDS_BI=LDS_OST+NW*4096, LDS_BYTES=LDS_BI+NW*NSLOT*256;
constexpr float C2=0.125f*1.4426950408889634f;
__device__ __forceinline__ void glds16(const void*gsrc,unsigned lds_dst){unsigned keep;
  asm volatile("s_mov_b32 %0, m0\n\ts_mov_b32 m0, %2\n\ts_nop 0\n\tglobal_load_lds_dwordx4 %1, off\n\ts_mov_b32 m0, %0":"=&s"(keep):"v"(gsrc),"s"(lds_dst):"memory");}
__device__ __forceinline__ void glds4(const void*gsrc,unsigned lds_dst){unsigned keep;
  asm volatile("s_mov_b32 %0, m0\n\ts_mov_b32 m0, %2\n\ts_nop 0\n\tglobal_load_lds_dword %1, off\n\ts_mov_b32 m0, %0":"=&s"(keep):"v"(gsrc),"s"(lds_dst):"memory");}
__device__ __forceinline__ void glds16s(const void*sbase,unsigned voff,unsigned lds_dst){unsigned keep;
  asm volatile("s_mov_b32 %0, m0\n\ts_mov_b32 m0, %3\n\ts_nop 0\n\tglobal_load_lds_dwordx4 %1, %2\n\ts_mov_b32 m0, %0":"=&s"(keep):"v"(voff),"s"(sbase),"s"(lds_dst):"memory");}
__device__ __forceinline__ void glds4s(const void*sbase,unsigned voff,unsigned lds_dst){unsigned keep;
  asm volatile("s_mov_b32 %0, m0\n\ts_mov_b32 m0, %3\n\ts_nop 0\n\tglobal_load_lds_dword %1, %2\n\ts_mov_b32 m0, %0":"=&s"(keep):"v"(voff),"s"(sbase),"s"(lds_dst):"memory");}
__device__ __forceinline__ float max3f(float a,float b,float c){float r;asm("v_max3_f32 %0, %1, %2, %3":"=v"(r):"v"(a),"v"(b),"v"(c));return r;}
__device__ __forceinline__ float max2f(float a,float b){float r;asm("v_max_f32_e32 %0, %1, %2":"=v"(r):"v"(a),"v"(b));return r;}
__device__ __forceinline__ float fadd_s(float a,float b){float r;asm("v_add_f32_e32 %0, %1, %2":"=v"(r):"v"(a),"v"(b));return r;}
__device__ __forceinline__ float fsub_s(float a,float b){float r;asm("v_sub_f32_e32 %0, %1, %2":"=v"(r):"v"(a),"v"(b));return r;}
typedef float f32x2_t __attribute__((ext_vector_type(2))); typedef __bf16 bf16x2_t __attribute__((ext_vector_type(2)));
__device__ __forceinline__ unsigned cvtpk_s(float lo,float hi){f32x2_t v={lo,hi};bf16x2_t b=__builtin_convertvector(v,bf16x2_t);return __builtin_bit_cast(unsigned,b);}
#define WAIT_BAR(N) asm volatile("s_waitcnt vmcnt(" #N ") lgkmcnt(0)\n\ts_barrier":::"memory")

__device__ __forceinline__ void qkt(f32x16&p0,f32x16&p1,const char*Kslot,const bf16x8*qr,int r32,int hi){
  const char*kb=Kslot+hi*1024+r32*16;
  #pragma unroll
  for(int d0=0;d0<4;++d0){
    const bf16x8 b0=*reinterpret_cast<const bf16x8*>(kb+d0*2048);
    const bf16x8 b1=*reinterpret_cast<const bf16x8*>(kb+d0*2048+512);
    {p0=__builtin_amdgcn_mfma_f32_32x32x16_bf16(b0,qr[d0],p0,0,0,0);p1=__builtin_amdgcn_mfma_f32_32x32x16_bf16(b1,qr[d0],p1,0,0,0);}}
}
typedef __attribute__((address_space(3))) const char* lds_cptr;
typedef short v4i16_t __attribute__((ext_vector_type(4)));
__device__ __forceinline__ void kload8(bf16x8*kf,lds_cptr kp){
  kf[0]=*(const __attribute__((address_space(3))) bf16x8*)(kp);      kf[1]=*(const __attribute__((address_space(3))) bf16x8*)(kp+512);
  kf[2]=*(const __attribute__((address_space(3))) bf16x8*)(kp+2048); kf[3]=*(const __attribute__((address_space(3))) bf16x8*)(kp+2560);
  kf[4]=*(const __attribute__((address_space(3))) bf16x8*)(kp+4096); kf[5]=*(const __attribute__((address_space(3))) bf16x8*)(kp+4608);
  kf[6]=*(const __attribute__((address_space(3))) bf16x8*)(kp+6144); kf[7]=*(const __attribute__((address_space(3))) bf16x8*)(kp+6656);
}
__device__ __forceinline__ void kload2(bf16x8*kf,lds_cptr kp,int j){ kf[2*j]=*(const __attribute__((address_space(3))) bf16x8*)(kp+j*2048); kf[2*j+1]=*(const __attribute__((address_space(3))) bf16x8*)(kp+j*2048+512); }
__device__ __forceinline__ s16x4 vtr(lds_cptr p){ return __builtin_bit_cast(s16x4,__builtin_amdgcn_ds_read_tr16_b64_v4i16((__attribute__((address_space(3))) v4i16_t*)p)); }
__device__ __forceinline__ float rowmax(const f32x16&p0,const f32x16&p1){
  float a=max3f(p0[0],p0[1],p1[0]),b=max3f(p0[2],p0[3],p1[1]);a=max3f(a,p1[2],p1[3]);
  #pragma unroll
  for(int r=4;r<16;r+=4){a=max3f(a,p0[r],p0[r+1]);b=max3f(b,p0[r+2],p0[r+3]);a=max3f(a,p1[r],p1[r+1]);b=max3f(b,p1[r+2],p1[r+3]);}
  const float m=max2f(a,b);
  auto rr=__builtin_amdgcn_permlane32_swap(__float_as_uint(m),__float_as_uint(m),false,false);
  return max2f(__uint_as_float(rr[0]),__uint_as_float(rr[1]));
}
__device__ __forceinline__ void pv(f32x16*o,int vb,bf16x8 pa0,bf16x8 pa1,bf16x8 pa2,bf16x8 pa3){
  #pragma unroll
  for(int d0=0;d0<2;++d0){s16x4 lo[4],hi[4];
    #pragma unroll
    for(int ks=0;ks<4;++ks){
      asm volatile("ds_read_b64_tr_b16 %0,%1 offset:%c2":"=&v"(lo[ks]):"v"(vb),"i"(d0*4096+ks*1024):"memory");
      asm volatile("ds_read_b64_tr_b16 %0,%1 offset:%c2":"=&v"(hi[ks]):"v"(vb),"i"(d0*4096+ks*1024+512):"memory");}
    asm volatile("s_waitcnt lgkmcnt(0)":::"memory");SBAR();
    #define PK(k) (bf16x8){lo[k][0],lo[k][1],lo[k][2],lo[k][3],hi[k][0],hi[k][1],hi[k][2],hi[k][3]}
    o[d0]=__builtin_amdgcn_mfma_f32_32x32x16_bf16(pa0,PK(0),o[d0],0,0,0);
    o[d0]=__builtin_amdgcn_mfma_f32_32x32x16_bf16(pa1,PK(1),o[d0],0,0,0);
    o[d0]=__builtin_amdgcn_mfma_f32_32x32x16_bf16(pa2,PK(2),o[d0],0,0,0);
    o[d0]=__builtin_amdgcn_mfma_f32_32x32x16_bf16(pa3,PK(3),o[d0],0,0,0);
    #undef PK
  }
}

#ifndef ATTN_STORE16
#define ATTN_STORE16(p,v) (*(u32x4*)(p)=(v))
#endif
template<int THRL> __device__ __forceinline__ void attn_unit(int b,int h,int qb,const bf16*Q,const bf16*__restrict__ K,const bf16*__restrict__ V,const bf16*__restrict__ G,const float*__restrict__ CB,float moff,int t0,bf16*O,char*shm){
  const int tid=mk_tid(),lane=tid&63,r32=lane&31,hi=lane>>5; const int wid=__builtin_amdgcn_readfirstlane(tid>>6);
  const long rowbase=(long)b*SEQ; const int q0=qb*QB;
  const bf16*Qw=Q+(rowbase+q0+wid*QBLK)*DM+h*D;
  const bf16*Kh=K+(rowbase+(long)t0*KVBLK)*DM+h*D,*Vh=V+(rowbase+(long)t0*KVBLK)*DM+h*D;
  const unsigned lds0=(unsigned)(uintptr_t)shm;
  const unsigned koff=(unsigned)(lane*DM+wid*8)*2u;
  const unsigned voff=(unsigned)((16*(wid&3)+(lane>>2))*DM+(wid>>2)*32+(lane&3)*8)*2u;
  const float*CBh=CB+((long)b*NHEAD+h)*SEQ; const unsigned boff=(unsigned)lane*4u;
  const unsigned kdst=lds0+LDS_K+wid*1024, vdst=lds0+LDS_V+wid*1024, bdst=lds0+LDS_BI+wid*(NSLOT*256);
  #define DMA_K(t,slot) do{ glds16s(Kh+(long)(t)*KVBLK*DM,koff,(unsigned)__builtin_amdgcn_readfirstlane(kdst+(slot))); glds4s(CBh+(long)((t)+t0)*KVBLK,boff,(unsigned)__builtin_amdgcn_readfirstlane(bdst+((slot)>>5))); }while(0)
  #define DMA_V(t,slot) glds16s(Vh+(long)(t)*KVBLK*DM,voff,(unsigned)__builtin_amdgcn_readfirstlane(vdst+(slot)))
  const char*Kbase=shm+LDS_K; bf16x8 kf[8];
  const lds_cptr shm3=(lds_cptr)shm; const lds_cptr kp0=shm3+LDS_K+hi*1024+r32*16; const lds_cptr vp0=shm3+LDS_V+((lane>>4)&1)*32+(lane&3)*8+(4*hi+((lane&15)>>2))*64;
  const int NT=(q0+QB)/KVBLK-t0;
  DMA_K(0,0);DMA_V(0,0);DMA_K(1,SLOTB);
  bf16x8 qr[4];
  #pragma unroll
  for(int d0=0;d0<4;++d0)qr[d0]=*reinterpret_cast<const bf16x8*>(&Qw[(long)r32*DM+d0*16+hi*8]);
  float l_reg=0.f;f32x16 o[2];o[0]=f32x16{};o[1]=f32x16{};
  const float cqm=CBh[q0+wid*QBLK+r32]-moff;
  typedef __attribute__((address_space(3))) const f32x4_t* lds_f4p;
  const lds_cptr bp0=(lds_cptr)shm+LDS_BI+wid*(NSLOT*256)+hi*16;
  #define BIAS_RD(P0,P1,sl) do{ const lds_f4p bq_=(lds_f4p)(bp0+((sl)>>5)); \
    _Pragma("unroll") for(int a_=0;a_<4;++a_){ const f32x4_t x0_=bq_[2*a_]; P0[4*a_]=x0_[0];P0[4*a_+1]=x0_[1];P0[4*a_+2]=x0_[2];P0[4*a_+3]=x0_[3]; } \
    _Pragma("unroll") for(int a_=0;a_<4;++a_){ const f32x4_t x1_=bq_[8+2*a_]; P1[4*a_]=x1_[0];P1[4*a_+1]=x1_[1];P1[4*a_+2]=x1_[2];P1[4*a_+3]=x1_[3]; } \
    asm volatile("":"+v"(P0),"+v"(P1)); }while(0)
  #define BIAS_SUB(P0,P1) do{ _Pragma("unroll") for(int r_=0;r_<16;++r_){ P0[r_]=cqm-P0[r_]; P1[r_]=cqm-P1[r_]; } }while(0)
  #define BIAS_LD(P0,P1,sl) do{ BIAS_RD(P0,P1,sl); BIAS_SUB(P0,P1); }while(0)
  #define CMASK(P0,P1,t) do{int jb_=(t)-(NT-4); if(jb_>=0){ int ln_=mk_tid()&63; asm volatile("":"+v"(ln_)); cmask(P0,P1,jb_,wid*QBLK+(ln_&31),ln_>>5);} }while(0)
  f32x16 pA0,pA1,pB0,pB1;
  int sl_prev=0,sl_cur=0,sl_next=SLOTB;
  #define ROT() do{sl_prev=sl_cur;sl_cur=sl_next;sl_next=(sl_next==(NSLOT-1)*SLOTB)?0:sl_next+SLOTB;}while(0)
  DMA_K(2,2*SLOTB);
  WAIT_BAR(5);
  BIAS_LD(pA0,pA1,0);
  qkt(pA0,pA1,Kbase,qr,r32,hi);asm volatile("s_nop 15\n\ts_nop 7":"+v"(pA0),"+v"(pA1));CMASK(pA0,pA1,0);
  _Pragma("unroll") for(int r=0;r<16;++r)pA0[r]=__builtin_amdgcn_exp2f(pA0[r]);
  _Pragma("unroll") for(int r=0;r<16;++r)pA1[r]=__builtin_amdgcn_exp2f(pA1[r]);
  WAIT_BAR(0);
  DMA_K(3,0);DMA_V(1,SLOTB);
  ROT();
  kload8(kf,kp0+sl_cur);
  BIAS_RD(pB0,pB1,sl_cur);
  WAIT_BAR(3);
  s16x4 vlo[8],vhi[8]; u32x4 pw0,pw1,pw2,pw3;
  #define PKW(P,B) cvtpk_s(P[B],P[B+1])
  #define PAF(k) __builtin_bit_cast(bf16x8,pw##k)
  #define VFR(i) (bf16x8){vlo[i][0],vlo[i][1],vlo[i][2],vlo[i][3],vhi[i][0],vhi[i][1],vhi[i][2],vhi[i][3]}
  #define PIN(x) asm volatile("":"+v"(x))
  #define MX3(a,b,c) __builtin_fmaxf(__builtin_fmaxf((a),(b)),(c))
  #define GAPA(MF,A0,A1,A2,A3,W0,W1,PW) do{ MF; sacc+=A0; sacc+=A1; sacc+=A2; sacc+=A3; PIN(sacc); W0; W1; PIN(PW); SBAR(); }while(0)
  #define EX(v) __builtin_amdgcn_exp2f(v)
  #define GAPB(MF,X,B) do{ MF; X[B]=EX(X[B]); X[B+1]=EX(X[B+1]); X[B+2]=EX(X[B+2]); X[B+3]=EX(X[B+3]); PIN(X); SBAR(); }while(0)
  #define VRD(i) do{ vlo[i]=vtr(vp_+(((i)>>2)*4096+((i)&3)*1024)); vhi[i]=vtr(vp_+(((i)>>2)*4096+((i)&3)*1024+512)); }while(0)
  #define KRD(G,j) do{ if(G){ kload2(kf,kp0+sl_next,j); SBAR(); } }while(0)
  #define STEP(C0,C1,P0,P1,t,GK,GV,GL) do{ SBAR(); BIAS_SUB(C0,C1); SBAR(); \
    const lds_cptr vp_=vp0+sl_prev; \
    VRD(0); SBAR(); float sacc=(P0[0]+P0[1]); \
    GAPA(C0=__builtin_amdgcn_mfma_f32_32x32x16_bf16(kf[0],qr[0],C0,0,0,0), P0[2],P0[3],P0[4],P0[5],     pw0[0]=PKW(P0,0), pw0[1]=PKW(P0,2), pw0); \
    VRD(4); SBAR(); GAPA(C1=__builtin_amdgcn_mfma_f32_32x32x16_bf16(kf[1],qr[0],C1,0,0,0), P0[6],P0[7],P0[8],P0[9],     pw0[2]=PKW(P0,4), pw0[3]=PKW(P0,6), pw0); \
    VRD(1); SBAR(); GAPA(C0=__builtin_amdgcn_mfma_f32_32x32x16_bf16(kf[2],qr[1],C0,0,0,0),   P0[10],P0[11],P0[12],P0[13], pw1[0]=PKW(P0,8), pw1[1]=PKW(P0,10), pw1); \
    VRD(5); SBAR(); GAPA(C1=__builtin_amdgcn_mfma_f32_32x32x16_bf16(kf[3],qr[1],C1,0,0,0),   P0[14],P0[15],P1[0],P1[1],   pw1[2]=PKW(P0,12),pw1[3]=PKW(P0,14), pw1); \
    VRD(2); SBAR(); GAPA(C0=__builtin_amdgcn_mfma_f32_32x32x16_bf16(kf[4],qr[2],C0,0,0,0),   P1[2],P1[3],P1[4],P1[5],     pw2[0]=PKW(P1,0), pw2[1]=PKW(P1,2), pw2); \
    VRD(6); SBAR(); GAPA(C1=__builtin_amdgcn_mfma_f32_32x32x16_bf16(kf[5],qr[2],C1,0,0,0),   P1[6],P1[7],P1[8],P1[9],     pw2[2]=PKW(P1,4), pw2[3]=PKW(P1,6), pw2); \
    VRD(3); SBAR(); GAPA(C0=__builtin_amdgcn_mfma_f32_32x32x16_bf16(kf[6],qr[3],C0,0,0,0),   P1[10],P1[11],P1[12],P1[13], pw3[0]=PKW(P1,8), pw3[1]=PKW(P1,10), pw3); \
    VRD(7); SBAR(); GAPA(C1=__builtin_amdgcn_mfma_f32_32x32x16_bf16(kf[7],qr[3],C1,0,0,0),   P1[14],P1[15],0.f,0.f,       pw3[2]=PKW(P1,12),pw3[3]=PKW(P1,14), pw3); \
    l_reg+=sacc; \
    if(GK){DMA_K((t)+3,sl_cur);} if(GV){DMA_V((t)+1,sl_next);} \
    CMASK(C0,C1,t); \
    SBAR(); \
    GAPB(o[0]=__builtin_amdgcn_mfma_f32_32x32x16_bf16(PAF(0),VFR(0),o[0],0,0,0), C0,0); \
    GAPB(o[1]=__builtin_amdgcn_mfma_f32_32x32x16_bf16(PAF(0),VFR(4),o[1],0,0,0), C0,4); \
    KRD(GL,0); GAPB(o[0]=__builtin_amdgcn_mfma_f32_32x32x16_bf16(PAF(1),VFR(1),o[0],0,0,0), C0,8); \
    KRD(GL,1); GAPB(o[1]=__builtin_amdgcn_mfma_f32_32x32x16_bf16(PAF(1),VFR(5),o[1],0,0,0), C0,12); \
    KRD(GL,2); GAPB(o[0]=__builtin_amdgcn_mfma_f32_32x32x16_bf16(PAF(2),VFR(2),o[0],0,0,0), C1,0); \
    KRD(GL,3); GAPB(o[1]=__builtin_amdgcn_mfma_f32_32x32x16_bf16(PAF(2),VFR(6),o[1],0,0,0), C1,4); \
    GAPB(o[0]=__builtin_amdgcn_mfma_f32_32x32x16_bf16(PAF(3),VFR(3),o[0],0,0,0), C1,8); \
    GAPB(o[1]=__builtin_amdgcn_mfma_f32_32x32x16_bf16(PAF(3),VFR(7),o[1],0,0,0), C1,12); \
    if(GL){ BIAS_RD(P0,P1,sl_next); } \
    }while(0)
  int t=1;
  #undef CMASK
  #define CMASK(P0,P1,t) do{}while(0)
  for(;t+5<NT;t+=2){
    STEP(pB0,pB1,pA0,pA1,t,true,true,true);     WAIT_BAR(3); ROT();
    STEP(pA0,pA1,pB0,pB1,t+1,true,true,true);   WAIT_BAR(3); ROT();
  }
  #undef CMASK
  #define CMASK(P0,P1,t) do{int jb_=(t)-(NT-4); if(jb_>=0){ int ln_=mk_tid()&63; asm volatile("":"+v"(ln_)); cmask(P0,P1,jb_,wid*QBLK+(ln_&31),ln_>>5);} }while(0)
  #define ENDW(tt) do{ if((tt)+3<NT){WAIT_BAR(3);} else if((tt)+2<NT){WAIT_BAR(1);} else {WAIT_BAR(0);} }while(0)
  for(;t+1<NT;t+=2){
    STEP(pB0,pB1,pA0,pA1,t,(t+3<NT),(t+1<NT),(t+1<NT));       ENDW(t);   ROT();
    STEP(pA0,pA1,pB0,pB1,t+1,(t+4<NT),(t+2<NT),(t+2<NT));     ENDW(t+1); ROT();
  }
  STEP(pB0,pB1,pA0,pA1,NT-1,false,false,false);
  { float sacc=pB0[0]+pB0[1]; _Pragma("unroll") for(int r=2;r<16;++r)sacc+=pB0[r]; _Pragma("unroll") for(int r=0;r<16;++r)sacc+=pB1[r]; l_reg+=sacc;
    pw0=(u32x4){PKW(pB0,0),PKW(pB0,2),PKW(pB0,4),PKW(pB0,6)};pw1=(u32x4){PKW(pB0,8),PKW(pB0,10),PKW(pB0,12),PKW(pB0,14)};pw2=(u32x4){PKW(pB1,0),PKW(pB1,2),PKW(pB1,4),PKW(pB1,6)};pw3=(u32x4){PKW(pB1,8),PKW(pB1,10),PKW(pB1,12),PKW(pB1,14)};
    int lane_v=mk_tid()&63; asm volatile("":"+v"(lane_v)); const int vb0=(int)(lds0+LDS_V)+((lane_v>>4)&1)*32+(lane_v&3)*8+(4*(lane_v>>5)+((lane_v&15)>>2))*64;
    SBAR(); pv(o,vb0+sl_cur,PAF(0),PAF(1),PAF(2),PAF(3)); }
  #undef PKW
  #undef PAF
  #undef VFR
  #undef PIN
  #undef MX3
  #undef GAPA
  #undef GAPB
  #undef EX
  #undef VRD
  #undef KRD
  #undef STEP
  #undef ENDW
  {auto rr=__builtin_amdgcn_permlane32_swap(__float_as_uint(l_reg),__float_as_uint(l_reg),false,false);l_reg=__uint_as_float(rr[0])+__uint_as_float(rr[1]);}
  float*wsf=(float*)(shm+LDS_WS)+wid*64;
  if(hi==0)wsf[32+r32]=l_reg;asm volatile("s_waitcnt lgkmcnt(0)":::"memory");
  float rli[16];
  #pragma unroll
  for(int r=0;r<16;++r)rli[r]=__builtin_amdgcn_rcpf(wsf[32+crow(r,hi)]);
  int qb_l=qb,b_l=b,h_l=h; asm volatile("":"+s"(qb_l),"+s"(b_l),"+s"(h_l)); int lane_l=mk_tid()&63; asm volatile("":"+v"(lane_l));
  const long eoff=((long)b_l*SEQ+qb_l*QB+wid*QBLK)*DM+h_l*D; bf16*Ow=O+eoff; const bf16*Gw=G+eoff;
  u32x4 gpre[4];
  #pragma unroll
  for(int i=0;i<4;++i)gpre[i]=*(const u32x4*)(Gw+(long)(i*8+(lane_l>>3))*DM+(lane_l&7)*8);
  { bf16*stg=(bf16*)(shm+LDS_OST)+wid*2048;
    #pragma unroll
    for(int r=0;r<16;++r){const int orow=crow(r,hi);
      #pragma unroll
      for(int d0=0;d0<2;++d0)stg[orow*64+d0*32+r32]=__float2bfloat16(o[d0][r]*rli[r]);}
    asm volatile("s_waitcnt lgkmcnt(0)":::"memory");
    #pragma unroll
    for(int i=0;i<4;++i){const int row=i*8+(lane_l>>3),ch=lane_l&7; u32x4 v=*(const u32x4*)(stg+row*64+ch*8); const u32x4 g=gpre[i];
      _Pragma("unroll") for(int e=0;e<4;++e){ const float a0=__uint_as_float(v[e]<<16)*__uint_as_float(g[e]<<16), a1=__uint_as_float(v[e]&0xffff0000u)*__uint_as_float(g[e]&0xffff0000u); v[e]=cvtpk_s(a0,a1); }
      ATTN_STORE16(Ow+(long)row*DM+ch*8,v);} }
  asm volatile("s_waitcnt lgkmcnt(0)":::"memory");
  #undef DMA_K
  #undef DMA_V
  #undef CMASK
  #undef BIAS_LD
  #undef BIAS_RD
  #undef BIAS_SUB
  #undef ROT
}
constexpr int ATTN_LDS_BYTES=LDS_BYTES;
struct AttnTensors { const bf16* Q; const bf16* K; const bf16* V; const bf16* G; const float* CB; const float* gq; const float* gk; bf16* O; unsigned* queue; const unsigned* nrm; };
struct AttnUnit { int bh; int qb; };
struct StaticOrder {
  int vcu;
  __device__ __forceinline__ explicit StaticOrder(int grid,int block):vcu((block%8)*(grid/8)+block/8){}
  __device__ __forceinline__ bool next(int i,AttnUnit&u)const{ if(i>=8)return false; const int s=vcu&7,j=i&3; u.bh=(vcu>>3)+32*(i>>2); u.qb=(j==0)?s:(j==1)?15-s:(j==2)?16+s:31-s; return true; }
  __device__ __forceinline__ void a_ready(const AttnUnit&)const{}
  __device__ __forceinline__ void done(const AttnUnit&)const{}
};
template<class Sched,int THRL=8> __device__ __forceinline__ void attn_phase(char*lds,const AttnTensors&T,const Sched&S){
  AttnUnit u; const int lane_=mk_tid()&63;
  float ga=fabsf(T.gq[lane_]),gb=fabsf(T.gk[lane_]);
  #pragma unroll
  for(int o_=32;o_;o_>>=1){ga=fmaxf(ga,__shfl_xor(ga,o_));gb=fmaxf(gb,__shfl_xor(gb,o_));}
  const float moff=8.0f*1.4426950408889634f*ga*gb;
  volatile __attribute__((address_space(3))) unsigned* qw=(volatile __attribute__((address_space(3))) unsigned*)(lds+LDS_BYTES);
  unsigned nxt=0u; if(mk_tid()==0) nxt=__hip_atomic_fetch_add(T.queue,1u,__ATOMIC_RELAXED,__HIP_MEMORY_SCOPE_AGENT);
  for(;;){
    if(mk_tid()==0){ *qw=nxt; nxt=__hip_atomic_fetch_add(T.queue,1u,__ATOMIC_RELAXED,__HIP_MEMORY_SCOPE_AGENT); }
    asm volatile("s_waitcnt lgkmcnt(0)\n\ts_barrier":::"memory");
    const unsigned idx=*qw;
    if(idx>=(unsigned)(BATCH*NHEAD*NQB)) break;
    const int qb=NQB-1-(int)(idx/(BATCH*NHEAD)), bh=(int)(idx%(BATCH*NHEAD));
    const float* cbh=T.CB+(long)bh*SEQ; const float cq0=cbh[qb*QB]; const int ntf=4*qb+4;
    const float nq2=__uint_as_float(T.nrm[bh]), nk2=__uint_as_float(T.nrm[64+bh]);
    const float cA=cbh[64*lane_+63], cB=cbh[64*(lane_+64)+63];
    const float lim=__builtin_amdgcn_exp2f(-26.0f-2.02f*__builtin_sqrtf(nq2*nk2));
    float eA=(lane_<ntf)?__builtin_amdgcn_exp2f(cq0-cA):0.f, eB=(lane_+64<ntf)?__builtin_amdgcn_exp2f(cq0-cB):0.f;
    #pragma unroll
    for(int o_=1;o_<64;o_<<=1){ const float a_=__shfl_up(eA,o_), b_=__shfl_up(eB,o_); if(lane_>=o_){eA+=a_;eB+=b_;} }
    eB+=__shfl(eA,63);
    const bool s0=(lane_<ntf)&(eA<=lim), s1=(lane_+64<ntf)&(eB<=lim);
    int t0=__popcll(__ballot(s0))+__popcll(__ballot(s1)); t0&=~1; if(t0>ntf-4)t0=ntf-4;
    attn_unit<THRL>(bh/NHEAD,bh%NHEAD,qb,T.Q,T.K,T.V,T.G,T.CB,moff,t0,T.O,lds);
  }
}
#undef SBAR
#undef WAIT_BAR
}
constexpr int NWAVES = 8;
constexpr int BATCH = 4, SEQ = 8192, D = 1024, FF = 4096, M = BATCH * SEQ;
constexpr int N0P = 3072, N1P = 4096;
constexpr int GH = 4, GDK = 128, GDV = 256, GC = 64, GNC = SEQ / GC, GUNITS = BATCH * GH * GNC;
constexpr float EPS = 1e-6f, LOG2E = 1.4426950408889634f;
constexpr size_t MiB = 1u << 20;
constexpr size_t WS_RSTD0 = 1 * MiB, WS_SSQ = 1 * MiB + 131072  , WS_LF = 2 * MiB, WS_CB = 4 * MiB, WS_DEC = 6 * MiB, WS_GLB = 7 * MiB  , WS_WG0 = 8 * MiB  , WS_WF1 = 8 * MiB + 65536;
constexpr size_t WS_WIN0 = 12 * MiB, WS_WOUT0 = 19 * MiB, WS_W1A = 21 * MiB, WS_W2A = 29 * MiB, WS_WIN1 = 37 * MiB, WS_WOUT1 = 46 * MiB, WS_W1B = 48 * MiB, WS_W2B = 56 * MiB;
constexpr size_t WS_XB = 64 * MiB, WS_PH = 128 * MiB, WS_PROJ0 = WS_PH, WS_Y0 = 336 * MiB, WS_U = WS_PH, WS_Q = 128 * MiB, WS_K = 192 * MiB, WS_V = 256 * MiB, WS_G = 320 * MiB, WS_O = 384 * MiB, WS_END = 448 * MiB;
constexpr int RING_BYTES = 131072, LDS_BYTES = 147456;
#define LAS __attribute__((address_space(3)))
typedef unsigned short bf16;
typedef unsigned v4u __attribute__((ext_vector_type(4)));
typedef unsigned v2u __attribute__((ext_vector_type(2)));
typedef float f32x4 __attribute__((ext_vector_type(4)));
typedef short bf16x8 __attribute__((ext_vector_type(8)));
typedef short s16x4 __attribute__((ext_vector_type(4)));
#define LDS_WAIT() asm volatile("s_waitcnt lgkmcnt(0)" ::: "memory")
typedef float f32x2_hw __attribute__((ext_vector_type(2))); typedef __bf16 bf16x2_hw __attribute__((ext_vector_type(2)));
__device__ __forceinline__ unsigned pk2(float lo, float hi) { const f32x2_hw v = {lo, hi}; return __builtin_bit_cast(unsigned, __builtin_convertvector(v, bf16x2_hw)); }
__device__ __forceinline__ unsigned f2bf(float f) { return pk2(f, 0.f) & 0xffffu; }
__device__ __forceinline__ float frcp(float x) { return __builtin_amdgcn_rcpf(x); }
__device__ __forceinline__ float frsq(float x) { return __builtin_amdgcn_rsqf(x); }
__device__ __forceinline__ float bf2f(bf16 v) { return __uint_as_float((unsigned)v << 16); }
__device__ __forceinline__ float bflo(unsigned w) { return __uint_as_float(w << 16); }
__device__ __forceinline__ float bfhi(unsigned w) { return __uint_as_float(w & 0xffff0000u); }
__device__ __forceinline__ float wave_sum(float v) {
#pragma unroll
    for (int o = 1; o < 64; o <<= 1) v += __shfl_xor(v, o);
    return v;
}
__device__ __forceinline__ float fexp(float x) { return __builtin_amdgcn_exp2f(x * 1.4426950408889634f); }
__device__ __forceinline__ float log_sigmoid(float z) { return fminf(z, 0.f) - __logf(1.0f + fexp(-fabsf(z))); }

struct Args { const float* in[20]; float* out; unsigned char* ws; int ph_lo, ph_hi; };
struct Frame { LAS unsigned char* lds; int tid, lane, wave, vcu, G; };

__device__ __forceinline__ int col_src(int mode, int c, int Norig) {
    if (mode == 0) return c < Norig ? c : -1;
    if (mode == 2) return c < 16 ? 3072 + c : -1;
    return c < 3072 ? c : (c < 4096 ? c + 16 : (c < 4112 ? c - 1024 : -1));
}
__device__ __forceinline__ void p0_transpose_item(const float* W, int K, int Norig, int Npad, int mode, const float* gain, bf16* WT, LAS float* scr, int item, int lane) {
    const int nblk = Npad / 32, kb = item / nblk, nb = item % nblk, k0 = 64 * kb, n0 = 32 * nb;
    const int c4 = lane & 7, sc = col_src(mode, n0 + 4 * c4, Norig);
    f32x4 v[8]; float gk[8];
    const char* wb = (const char*)(W + (size_t)k0 * Norig); const unsigned wo = (unsigned)((lane >> 3) * Norig + (sc >= 0 ? sc : 0)) * 4u;
    const float* gp = gain ? gain + k0 : W;
#pragma unroll
    for (int i = 0; i < 8; ++i) { v[i] = __builtin_nontemporal_load((const f32x4*)(wb + (size_t)(8 * i) * Norig * 4 + wo)); gk[i] = gp[8 * i + (lane >> 3)]; }
#pragma unroll
    for (int i = 0; i < 8; ++i) { const int kk = 8 * i + (lane >> 3); f32x4 w = v[i]; const float gm = gain ? gk[i] : 1.0f; w = w * (sc >= 0 ? gm : 0.0f);
        LAS float* d = scr + kk * 33 + 4 * c4; d[0] = w[0]; d[1] = w[1]; d[2] = w[2]; d[3] = w[3]; }
    LDS_WAIT(); asm volatile("" ::: "memory");
    const int c = lane & 7;
    const int prow0 = (n0 & ~255) + 128 * ((n0 >> 5) & 1) + 32 * ((n0 >> 6) & 3);
#pragma unroll
    for (int j = 0; j < 4; ++j) { const int n = (lane >> 3) + 8 * j; const LAS float* s = scr + (8 * c) * 33 + n;
        v4u o; o.x = pk2(s[0 * 33], s[1 * 33]); o.y = pk2(s[2 * 33], s[3 * 33]); o.z = pk2(s[4 * 33], s[5 * 33]); o.w = pk2(s[6 * 33], s[7 * 33]);
        *(v4u*)(WT + (size_t)(prow0 + n) * K + k0 + 8 * c) = o; }
    LDS_WAIT(); asm volatile("" ::: "memory");
}
__device__ __forceinline__ void p0_prologue(Frame& F, const Args& a) {
    LAS float* scr = (LAS float*)(F.lds + F.wave * 16384);
    unsigned char* ws = a.ws;
    const int gw = F.vcu * NWAVES + F.wave, NGW = F.G * NWAVES;
    constexpr int I0 = (D / 64) * (N0P / 32), I1 = (D / 64) * (D / 32), I2 = (D / 64) * (FF / 32), I3 = (FF / 64) * (D / 32), I4 = (D / 64) * (N1P / 32);
    constexpr int IT = D / 64;
    constexpr int NITEMS = I0 + I1 + I2 + I3 + I4 + I1 + I2 + I3 + 2 * IT;
#pragma unroll 1
    for (int it = gw; it < NITEMS; it += NGW) {
        int r = it;
        if (r < I0) { p0_transpose_item(a.in[2], D, 3088, N0P, 0, a.in[1], (bf16*)(ws + WS_WIN0), scr, r, F.lane); continue; } r -= I0;
        if (r < I1) { p0_transpose_item(a.in[6], D, D, D, 0, nullptr, (bf16*)(ws + WS_WOUT0), scr, r, F.lane); continue; } r -= I1;
        if (r < I2) { p0_transpose_item(a.in[8], D, FF, FF, 0, a.in[7], (bf16*)(ws + WS_W1A), scr, r, F.lane); continue; } r -= I2;
        if (r < I3) { p0_transpose_item(a.in[9], FF, D, D, 0, nullptr, (bf16*)(ws + WS_W2A), scr, r, F.lane); continue; } r -= I3;
        if (r < I4) { p0_transpose_item(a.in[11], D, 4112, N1P, 1, a.in[10], (bf16*)(ws + WS_WIN1), scr, r, F.lane); continue; } r -= I4;
        if (r < I1) { p0_transpose_item(a.in[15], D, D, D, 0, nullptr, (bf16*)(ws + WS_WOUT1), scr, r, F.lane); continue; } r -= I1;
        if (r < I2) { p0_transpose_item(a.in[17], D, FF, FF, 0, a.in[16], (bf16*)(ws + WS_W1B), scr, r, F.lane); continue; } r -= I2;
        if (r < I3) { p0_transpose_item(a.in[18], FF, D, D, 0, nullptr, (bf16*)(ws + WS_W2B), scr, r, F.lane); continue; } r -= I3;
        if (r < IT) { p0_transpose_item(a.in[2], D, 3088, 32, 2, a.in[1], (bf16*)(ws + WS_WG0), scr, r, F.lane); continue; } r -= IT;
        p0_transpose_item(a.in[11], D, 4112, 32, 2, a.in[10], (bf16*)(ws + WS_WF1), scr, r, F.lane);
    }
    const float* x = a.in[0]; bf16* XB = (bf16*)(ws + WS_XB); float* rstd0 = (float*)(ws + WS_RSTD0);
    { int m = 2 * gw; f32x4 v[8];
      if (m < M) { const f32x4* xr = (const f32x4*)(x + (size_t)m * D) + F.lane;
#pragma unroll
          for (int j = 0; j < 8; ++j) v[j] = __builtin_nontemporal_load(xr + 64 * j); }
#pragma unroll 1
      for (; m < M; m += 2 * NGW) { const int mn = m + 2 * NGW; f32x4 w[8];
          if (mn < M) { const f32x4* xn = (const f32x4*)(x + (size_t)mn * D) + F.lane;
#pragma unroll
              for (int j = 0; j < 8; ++j) w[j] = __builtin_nontemporal_load(xn + 64 * j); }
          float s0 = 0.f, s1 = 0.f;
#pragma unroll
          for (int j = 0; j < 4; ++j) { s0 += (v[j].x * v[j].x + v[j].y * v[j].y) + (v[j].z * v[j].z + v[j].w * v[j].w); s1 += (v[4 + j].x * v[4 + j].x + v[4 + j].y * v[4 + j].y) + (v[4 + j].z * v[4 + j].z + v[4 + j].w * v[4 + j].w); }
          s0 = wave_sum(s0); s1 = wave_sum(s1);
          if (F.lane == 0) { rstd0[m] = frsq(s0 * (1.0f / D) + EPS); rstd0[m + 1] = frsq(s1 * (1.0f / D) + EPS); }
          v2u* o8 = (v2u*)(XB + (size_t)m * D) + F.lane;
#pragma unroll
          for (int j = 0; j < 8; ++j) { v2u pw; pw.x = pk2(v[j].x, v[j].y); pw.y = pk2(v[j].z, v[j].w); o8[64 * j] = pw; }
#pragma unroll
          for (int j = 0; j < 8; ++j) v[j] = w[j]; } }
    float* ssq = (float*)(ws + WS_SSQ);
    for (int i = (F.vcu * NWAVES * 64) + F.tid; i < 4 * M; i += F.G * NWAVES * 64) ssq[i] = 0.f;
}

struct GlaPre { v4u v[4]; v4u q[2]; v4u k[2]; v4u g; };
template <bool WANT_Q> __device__ __forceinline__ void gla_prefetch(GlaPre& P, const bf16* prow, const bf16* grow, int h, int tid) {
    const char* pb = (const char*)prow;
    const unsigned ov = (unsigned)(tid >> 5) * (N0P * 2) + (unsigned)(tid & 31) * 16, ok = (unsigned)(tid >> 4) * (N0P * 2) + (unsigned)(tid & 15) * 16, og = (unsigned)(tid & 127) * 16;
#pragma unroll
    for (int i = 0; i < 4; ++i) P.v[i] = *(const v4u*)(pb + ((size_t)(16 * i) * N0P + 1024 + h * 256) * 2 + ov);
#pragma unroll
    for (int i = 0; i < 2; ++i) { P.k[i] = *(const v4u*)(pb + ((size_t)(32 * i) * N0P + 512 + h * 128) * 2 + ok); if (WANT_Q) P.q[i] = *(const v4u*)(pb + ((size_t)(32 * i) * N0P + h * 128) * 2 + ok); }
    P.g = *(const v4u*)((const char*)grow + og);
}
constexpr int VSTR = 544, QSTR = 272, KDSTR = 144;
template <bool WANT_Q> __device__ __forceinline__ void gla_stage(const GlaPre& P, LAS unsigned char* Vs, LAS unsigned char* Ks, LAS unsigned char* Qs, LAS float* gl, int tid) {
#pragma unroll
    for (int i = 0; i < 4; ++i) { const int p = tid + 512 * i, t = p >> 5, ch = p & 31; *(LAS v4u*)(Vs + t * VSTR + ch * 16) = P.v[i]; }
#pragma unroll
    for (int i = 0; i < 2; ++i) { const int p = tid + 512 * i, t = p >> 4, ch = p & 15; *(LAS v4u*)(Ks + t * QSTR + ch * 16) = P.k[i]; if (WANT_Q) *(LAS v4u*)(Qs + t * QSTR + ch * 16) = P.q[i]; }
    if (tid < 128) *(LAS v4u*)((LAS unsigned char*)gl + tid * 16) = P.g;
}
#define MFMA16(a, b, c) __builtin_amdgcn_mfma_f32_16x16x32_bf16(a, b, c, 0, 0, 0)
__device__ __forceinline__ void gla_gate_mfma(const bf16x8 wuf, float bias, const LAS unsigned char* gl16, int l15, int g, float (&bl)[4][4], float& blast) {
    float carry = 0.f;
#pragma unroll
    for (int mt = 0; mt < 4; ++mt) {
        bf16x8 af = *(const LAS bf16x8*)(gl16 + (16 * mt + l15) * 32 + (g & 1) * 16); if (g >= 2) af = (bf16x8){0, 0, 0, 0, 0, 0, 0, 0};
        const f32x4 z = MFMA16(af, wuf, ((f32x4){bias, bias, bias, bias}));
        float p[4]; float run = 0.f;
#pragma unroll
        for (int r = 0; r < 4; ++r) { run += log_sigmoid(z[r]) * (1.0f / 16.0f); p[r] = run; }
        const float x1 = __shfl_up(run, 16), x2 = __shfl_up(run, 32), x3 = __shfl_up(run, 48);
        const float e = (g >= 1 ? x1 : 0.f) + (g >= 2 ? x2 : 0.f) + (g >= 3 ? x3 : 0.f);
        float tt = run + __shfl_xor(run, 16); tt += __shfl_xor(tt, 32);
#pragma unroll
        for (int r = 0; r < 4; ++r) bl[mt][r] = carry + e + p[r];
        carry += tt; }
    blast = carry;
}
__device__ __forceinline__ bf16x8 gla_wu_frag(const float* wup, int h, int w, int l15, int g) {
    const float* p = wup + (size_t)(8 * (g & 1)) * 512 + h * 128 + 16 * w + l15; float v[8];
#pragma unroll
    for (int j = 0; j < 8; ++j) v[j] = p[j * 512];
    v4u o; o.x = pk2(v[0], v[1]); o.y = pk2(v[2], v[3]); o.z = pk2(v[4], v[5]); o.w = pk2(v[6], v[7]);
    if (g >= 2) o = (v4u){0u, 0u, 0u, 0u};
    return __builtin_bit_cast(bf16x8, o);
}
__device__ __forceinline__ s16x4 tr16(const LAS unsigned char* p) { typedef short v4i16_t __attribute__((ext_vector_type(4))); return __builtin_bit_cast(s16x4, __builtin_amdgcn_ds_read_tr16_b64_v4i16((LAS v4i16_t*)p)); }
__device__ __forceinline__ void gla_pass_a(Frame& F, const Args& a) {
    const int tid = F.tid, lane = F.lane, w = F.wave, l15 = lane & 15, g = lane >> 4, c = tid & 127, tg = tid >> 7;
    LAS float* gl = (LAS float*)F.lds; LAS float* tot = (LAS float*)(F.lds + 4096); LAS unsigned char* Ks = F.lds + 8192; LAS unsigned char* KdT = F.lds + 25600; LAS unsigned char* Vs = F.lds + 45056;
    const bf16* proj = (const bf16*)(a.ws + WS_PROJ0); const bf16* glb = (const bf16*)(a.ws + WS_GLB);
    GlaPre P; int unit = F.vcu;
    if (unit < GUNITS) { const int bh = unit >> 7, n = unit & 127; gla_prefetch<false>(P, proj + ((size_t)(bh >> 2) * SEQ + (size_t)n * GC) * N0P, glb + ((size_t)(bh >> 2) * SEQ + (size_t)n * GC) * 16, bh & 3, tid); }
    for (; unit < GUNITS; unit += F.G) {
        const int bh = unit >> 7, h = bh & 3;
        gla_stage<false>(P, Vs, Ks, nullptr, gl, tid);
        const bf16x8 wuf = gla_wu_frag(a.in[3], h, w, l15, g); const float bias = a.in[4][h * 128 + 16 * w + l15];
        __syncthreads();
        { int nu = unit + F.G; if (nu >= GUNITS) nu = unit;        { const int nbh = nu >> 7, nn = nu & 127; gla_prefetch<false>(P, proj + ((size_t)(nbh >> 2) * SEQ + (size_t)nn * GC) * N0P, glb + ((size_t)(nbh >> 2) * SEQ + (size_t)nn * GC) * 16, nbh & 3, tid); } }
        float bl[4][4], blast;
        gla_gate_mfma(wuf, bias, (const LAS unsigned char*)gl, l15, g, bl, blast);
        { const int cc = 16 * w + l15;
#pragma unroll
          for (int mt = 0; mt < 4; ++mt) { float kd[4];
#pragma unroll
              for (int r = 0; r < 4; ++r) kd[r] = bf2f(*(const LAS bf16*)(Ks + (16 * mt + 4 * g + r) * QSTR + cc * 2)) * fexp(blast - bl[mt][r]);
              v2u o; o.x = pk2(kd[0], kd[1]); o.y = pk2(kd[2], kd[3]); *(LAS v2u*)(KdT + cc * KDSTR + (16 * mt + 4 * g) * 2) = o; }
          if (g == 0) ((float*)(a.ws + WS_DEC))[(size_t)unit * 128 + cc] = fexp(blast); }
        __syncthreads();
        f32x4 acc[2][8];
#pragma unroll
        for (int mt = 0; mt < 2; ++mt)
#pragma unroll
            for (int nt = 0; nt < 8; ++nt) acc[mt][nt] = (f32x4){0.f, 0.f, 0.f, 0.f};
#pragma unroll
        for (int s = 0; s < 2; ++s) { bf16x8 vf[2];
#pragma unroll
            for (int mt = 0; mt < 2; ++mt) { const LAS unsigned char* p = Vs + (32 * s + 4 * g + (l15 >> 2)) * VSTR + (32 * w + 16 * mt + 4 * (l15 & 3)) * 2;
                const s16x4 lo = tr16(p), hi = tr16(p + 16 * VSTR); vf[mt] = (bf16x8){lo[0], lo[1], lo[2], lo[3], hi[0], hi[1], hi[2], hi[3]}; }
#pragma unroll
            for (int nt = 0; nt < 8; ++nt) { const LAS unsigned char* p = KdT + (16 * nt + l15) * KDSTR + (32 * s + 4 * g) * 2;
                const s16x4 lo = *(const LAS s16x4*)p, hi = *(const LAS s16x4*)(p + 32); const bf16x8 kf = (bf16x8){lo[0], lo[1], lo[2], lo[3], hi[0], hi[1], hi[2], hi[3]};
#pragma unroll
                for (int mt = 0; mt < 2; ++mt) acc[mt][nt] = MFMA16(kf, vf[mt], acc[mt][nt]); } }
        bf16* S = (bf16*)a.out + (size_t)unit * 256 * 128;
#pragma unroll
        for (int mt = 0; mt < 2; ++mt)
#pragma unroll
            for (int nt = 0; nt < 8; ++nt) { v2u o; o.x = pk2(acc[mt][nt][0], acc[mt][nt][1]); o.y = pk2(acc[mt][nt][2], acc[mt][nt][3]);
                *(v2u*)((char*)S + (size_t)(32 * w + 16 * mt) * 256 + nt * 32 + (unsigned)(l15 * 256 + g * 8)) = o; }
        __syncthreads();
    }
}
__device__ __forceinline__ void gla_scan(Frame& F, const Args& a) {
    bf16* S = (bf16*)a.out; const float* dec = (const float*)(a.ws + WS_DEC);
    for (int id = F.vcu * 512 + F.tid; id < 16 * 256 * 32; id += F.G * 512) { const int c4 = id & 31, dv = (id >> 5) & 255, bh = id >> 13;
        float st[4] = {0.f, 0.f, 0.f, 0.f};
        v2u sl[16]; f32x4 d[16];
        { const char* pb = (const char*)(S + (((size_t)bh * GNC) * 256 + dv) * 128 + c4 * 4); const char* db = (const char*)(dec + ((size_t)bh * GNC) * 128 + c4 * 4);
#pragma unroll
          for (int j = 0; j < 16; ++j) { sl[j] = *(const v2u*)(pb + (size_t)j * 65536); d[j] = *(const f32x4*)(db + (size_t)j * 512); } }
#pragma unroll 1
        for (int n0 = 0; n0 < GNC; n0 += 16) {
            char* pb = (char*)(S + (((size_t)bh * GNC + n0) * 256 + dv) * 128 + c4 * 4);
            v2u sn[16]; f32x4 dn[16];
            if (n0 + 16 < GNC) { const char* pn = pb + (size_t)16 * 65536; const char* dnb = (const char*)(dec + ((size_t)bh * GNC + n0 + 16) * 128 + c4 * 4);
#pragma unroll
                for (int j = 0; j < 16; ++j) { sn[j] = *(const v2u*)(pn + (size_t)j * 65536); dn[j] = *(const f32x4*)(dnb + (size_t)j * 512); } }
#pragma unroll
            for (int j = 0; j < 16; ++j) { v2u o; o.x = pk2(st[0], st[1]); o.y = pk2(st[2], st[3]); *(v2u*)(pb + (size_t)j * 65536) = o;
                st[0] = st[0] * d[j][0] + bflo(sl[j].x); st[1] = st[1] * d[j][1] + bfhi(sl[j].x); st[2] = st[2] * d[j][2] + bflo(sl[j].y); st[3] = st[3] * d[j][3] + bfhi(sl[j].y); }
#pragma unroll
            for (int j = 0; j < 16; ++j) { sl[j] = sn[j]; d[j] = dn[j]; } } }
}
__device__ __forceinline__ void gla_pass_c(Frame& F, const Args& a) {
    const int tid = F.tid, lane = F.lane, w = F.wave, l15 = lane & 15, g = lane >> 4, c = tid & 127, tg = tid >> 7;
    LAS float* gl = (LAS float*)F.lds; LAS float* tot = (LAS float*)(F.lds + 4096); LAS float* ssqx = (LAS float*)(F.lds + 6144);
    LAS unsigned char* Qs = F.lds + 8192; LAS unsigned char* Ks = F.lds + 25600; LAS unsigned char* Vs = F.lds + 43008;
    const bf16* proj = (const bf16*)(a.ws + WS_PROJ0); const bf16* glb = (const bf16*)(a.ws + WS_GLB);
    const float qsc = 0.08838834764831845f;
    f32x4 gon[2];
#pragma unroll
    for (int nt = 0; nt < 2; ++nt) gon[nt] = *(const f32x4*)(a.in[5] + 32 * w + 16 * nt + 4 * g);
    GlaPre P; int unit = F.vcu;
    if (unit < GUNITS) { const int bh = unit >> 7, n = unit & 127; gla_prefetch<true>(P, proj + ((size_t)(bh >> 2) * SEQ + (size_t)n * GC) * N0P, glb + ((size_t)(bh >> 2) * SEQ + (size_t)n * GC) * 16, bh & 3, tid); }
    for (; unit < GUNITS; unit += F.G) {
        const int bh = unit >> 7, n = unit & 127, b = bh >> 2, h = bh & 3; const size_t row0 = (size_t)b * SEQ + (size_t)n * GC;
        const bf16* prow = proj + row0 * N0P;
        gla_stage<true>(P, Vs, Ks, Qs, gl, tid);
        const bf16x8 wuf = gla_wu_frag(a.in[3], h, w, l15, g); const float bias = a.in[4][h * 128 + 16 * w + l15];
        __syncthreads();
        { int nu = unit + F.G; if (nu >= GUNITS) nu = unit;        { const int nbh = nu >> 7, nn = nu & 127; gla_prefetch<true>(P, proj + ((size_t)(nbh >> 2) * SEQ + (size_t)nn * GC) * N0P, glb + ((size_t)(nbh >> 2) * SEQ + (size_t)nn * GC) * 16, nbh & 3, tid); } }
        float bl[4][4], blast;
        gla_gate_mfma(wuf, bias, (const LAS unsigned char*)gl, l15, g, bl, blast);
        const bf16* Sp = (const bf16*)a.out + (size_t)unit * 256 * 128;
        bf16x8 Sf[4][2]; v2u rv[4][2];
        { const char* sb = (const char*)Sp + (size_t)(32 * w) * 256; const unsigned so = (unsigned)l15 * 256 + (unsigned)g * 16;
#pragma unroll
          for (int kc = 0; kc < 4; ++kc)
#pragma unroll
              for (int nt = 0; nt < 2; ++nt) Sf[kc][nt] = *(const bf16x8*)(sb + nt * 4096 + kc * 64 + so);
          const char* rb = (const char*)prow + (size_t)(2048 + h * 256 + 32 * w) * 2; const unsigned ro = (unsigned)l15 * (N0P * 2) + (unsigned)g * 8;
#pragma unroll
          for (int it = 0; it < 4; ++it)
#pragma unroll
              for (int nt = 0; nt < 2; ++nt) rv[it][nt] = *(const v2u*)(rb + (size_t)(16 * it) * (N0P * 2) + nt * 32 + ro); }
        { const int cc = 16 * w + l15;
#pragma unroll
          for (int mt = 0; mt < 4; ++mt)
#pragma unroll
              for (int r = 0; r < 4; ++r) { const int t = 16 * mt + 4 * g + r; LAS bf16* qp = (LAS bf16*)(Qs + t * QSTR + cc * 2); LAS bf16* kp = (LAS bf16*)(Ks + t * QSTR + cc * 2);
                  *qp = (bf16)f2bf(bf2f(*qp) * qsc * fexp(bl[mt][r])); *kp = (bf16)f2bf(bf2f(*kp) * fexp(-bl[mt][r])); } }
        __syncthreads();
        v4u pf[4][2];
#pragma unroll
        for (int it = 0; it < 4; ++it) { pf[it][0] = (v4u){0u, 0u, 0u, 0u}; pf[it][1] = (v4u){0u, 0u, 0u, 0u}; }
#pragma unroll
        for (int it = 0; it < 4; ++it) { bf16x8 Qf[4];
#pragma unroll
            for (int kc = 0; kc < 4; ++kc) Qf[kc] = *(const LAS bf16x8*)(Qs + (16 * it + l15) * QSTR + (32 * kc + 8 * g) * 2);
#pragma unroll
            for (int jt = 0; jt <= it; ++jt) { f32x4 at = (f32x4){0.f, 0.f, 0.f, 0.f};
#pragma unroll
                for (int kc = 0; kc < 4; ++kc) { const bf16x8 Kf = *(const LAS bf16x8*)(Ks + (16 * jt + l15) * QSTR + (32 * kc + 8 * g) * 2); at = MFMA16(Kf, Qf[kc], at); }
                if (it == jt) {
#pragma unroll
                    for (int r = 0; r < 4; ++r) if (4 * g + r > l15) at[r] = 0.f; }
                const unsigned lo = pk2(at[0], at[1]), hi = pk2(at[2], at[3]);
                if (jt & 1) { pf[it][jt >> 1].z = lo; pf[it][jt >> 1].w = hi; } else { pf[it][jt >> 1].x = lo; pf[it][jt >> 1].y = hi; } }
            asm volatile("" ::: "memory"); }
        f32x4 acc[4][2];
#pragma unroll
        for (int it = 0; it < 4; ++it) { acc[it][0] = (f32x4){0.f, 0.f, 0.f, 0.f}; acc[it][1] = (f32x4){0.f, 0.f, 0.f, 0.f}; }
#pragma unroll
        for (int s = 0; s < 2; ++s)
#pragma unroll
            for (int nt = 0; nt < 2; ++nt) { const LAS unsigned char* p = Vs + (32 * s + 4 * g + (l15 >> 2)) * VSTR + (32 * w + 16 * nt + 4 * (l15 & 3)) * 2;
                const s16x4 lo = tr16(p), hi = tr16(p + 16 * VSTR); const bf16x8 vf = (bf16x8){lo[0], lo[1], lo[2], lo[3], hi[0], hi[1], hi[2], hi[3]};
#pragma unroll
                for (int it = 0; it < 4; ++it) acc[it][nt] = MFMA16(vf, __builtin_bit_cast(bf16x8, pf[it][s]), acc[it][nt]); }
#pragma unroll
        for (int it = 0; it < 4; ++it) { bf16x8 Qf[4];
#pragma unroll
            for (int kc = 0; kc < 4; ++kc) Qf[kc] = *(const LAS bf16x8*)(Qs + (16 * it + l15) * QSTR + (32 * kc + 8 * g) * 2);
#pragma unroll
            for (int kc = 0; kc < 4; ++kc)
#pragma unroll
                for (int nt = 0; nt < 2; ++nt) acc[it][nt] = MFMA16(Sf[kc][nt], Qf[kc], acc[it][nt]);
            asm volatile("" ::: "memory"); }
#pragma unroll
        for (int it = 0; it < 4; ++it) { float s = 0.f;
#pragma unroll
            for (int nt = 0; nt < 2; ++nt) s += (acc[it][nt][0] * acc[it][nt][0] + acc[it][nt][1] * acc[it][nt][1]) + (acc[it][nt][2] * acc[it][nt][2] + acc[it][nt][3] * acc[it][nt][3]);
            s += __shfl_xor(s, 16); s += __shfl_xor(s, 32);
            if (g == 0) ssqx[(16 * it + l15) * 8 + w] = s; }
        __syncthreads();
        char* yb = (char*)((bf16*)(a.ws + WS_Y0) + row0 * 1024 + h * 256 + 32 * w); const unsigned yo = (unsigned)l15 * 2048 + (unsigned)g * 8;
#pragma unroll
        for (int it = 0; it < 4; ++it) { const LAS f32x4* sp = (const LAS f32x4*)(ssqx + (16 * it + l15) * 8); const f32x4 s0 = sp[0], s1 = sp[1];
            const float rstd = frsq(((s0[0] + s0[1]) + (s0[2] + s0[3]) + (s1[0] + s1[1]) + (s1[2] + s1[3])) * (1.0f / 256.0f) + EPS);
#pragma unroll
            for (int nt = 0; nt < 2; ++nt) { const float r0 = bflo(rv[it][nt].x), r1 = bfhi(rv[it][nt].x), r2 = bflo(rv[it][nt].y), r3 = bfhi(rv[it][nt].y);
                const f32x4 o = acc[it][nt] * rstd * gon[nt];
                v2u y; y.x = pk2(o[0] * (r0 * frcp(1.0f + fexp(-r0))), o[1] * (r1 * frcp(1.0f + fexp(-r1)))); y.y = pk2(o[2] * (r2 * frcp(1.0f + fexp(-r2))), o[3] * (r3 * frcp(1.0f + fexp(-r3))));
                *(v2u*)(yb + (size_t)(16 * it) * 2048 + nt * 32 + yo) = y; } }
        __syncthreads();
    }
}

template <int MODE  >
__device__ __forceinline__ void thin_gemm16(Frame& F, const bf16* A, const bf16* Wt, const float* rs, const float* bfg, void* out) {
    const int l15 = F.lane & 15, g = F.lane >> 4;
    for (int blk = F.vcu * NWAVES + F.wave; blk < M / 16; blk += F.G * NWAVES) {
        const char* ab = (const char*)(A + (size_t)blk * 16 * D); const unsigned ao = (unsigned)l15 * (D * 2) + (unsigned)g * 16;
        const char* wb = (const char*)Wt;
        f32x4 acc = (f32x4){0.f, 0.f, 0.f, 0.f};
#pragma unroll
        for (int kb = 0; kb < 2; ++kb) { bf16x8 af[16], wf[16];
#pragma unroll
            for (int s = 0; s < 16; ++s) { af[s] = *(const bf16x8*)(ab + (kb * 16 + s) * 64 + ao); wf[s] = *(const bf16x8*)(wb + (kb * 16 + s) * 64 + ao); }
#pragma unroll
            for (int s = 0; s < 16; ++s) acc = MFMA16(af[s], wf[s], acc);
            asm volatile("" ::: "memory"); }
        float rv[4];
#pragma unroll
        for (int r = 0; r < 4; ++r) rv[r] = rs[blk * 16 + 4 * g + r];
        const float bb = MODE == 1 ? bfg[l15] : 0.f;
#pragma unroll
        for (int r = 0; r < 4; ++r) { const int row = blk * 16 + 4 * g + r;
            if (MODE == 0) { ((bf16*)out)[(size_t)row * 16 + l15] = (bf16)f2bf(acc[r] * rv[r]); }
            else { const float z = acc[r] * (frsq(rv[r] * (1.0f / D) + EPS)) + bb; ((float*)out)[(size_t)row * 16 + l15] = log_sigmoid(z) * LOG2E; } }
    }
}
__device__ __forceinline__ void fox_cumsum(Frame& F, const Args& a) {
    const float* LF = (const float*)(a.ws + WS_LF); float* CB = (float*)(a.ws + WS_CB); LAS double* wt = (LAS double*)F.lds;
    for (int item = F.vcu; item < BATCH * 16 * 4; item += F.G) { const int bh = item >> 2, q = item & 3, b = bh >> 4, h = bh & 15;
        const float* src = LF + (size_t)b * SEQ * 16 + h;
        double carry = 0.0;
        { float cv[12];
#pragma unroll
          for (int j = 0; j < 12; ++j) { const int p = F.tid + 512 * j; cv[j] = src[(size_t)(p < 2048 * q ? p : 0) * 16]; }
#pragma unroll
          for (int j = 0; j < 12; ++j) carry += (F.tid + 512 * j < 2048 * q) ? (double)cv[j] : 0.0; }
#pragma unroll
        for (int o = 1; o < 64; o <<= 1) carry += __shfl_xor(carry, o);
        double loc[4]; double run = 0.0; const int p0 = 2048 * q + 4 * F.tid;
#pragma unroll
        for (int e = 0; e < 4; ++e) { run += (double)src[(size_t)(p0 + e) * 16]; loc[e] = run; }
        double inc = run;
#pragma unroll
        for (int o = 1; o < 64; o <<= 1) { const double v = __shfl_up(inc, o); if (F.lane >= o) inc += v; }
        if (F.lane == 63) { wt[F.wave] = inc; wt[8 + F.wave] = carry; }
        __syncthreads();
        double off = inc - run;
        for (int w = 0; w < NWAVES; ++w) { off += wt[8 + w]; if (w < F.wave) off += wt[w]; }
#pragma unroll
        for (int e = 0; e < 4; ++e) CB[(size_t)bh * SEQ + p0 + e] = (float)(off + loc[e]);
        __syncthreads();
    }
}
__device__ __forceinline__ void final_norm(Frame& F, const Args& a) {
    const int gw = F.vcu * NWAVES + F.wave, NGW = F.G * NWAVES; const float* ssq = (const float*)(a.ws + WS_SSQ) + 3 * M; const float* gf = a.in[19]; const bf16* XB = (const bf16*)(a.ws + WS_XB);
    f32x4 gv[4];
#pragma unroll
    for (int j = 0; j < 4; ++j) gv[j] = ((const f32x4*)gf)[F.lane + 64 * j];
    int m = 2 * gw; v2u v[8]; float q0 = 0.f, q1 = 0.f;
    if (m < M) { const v2u* xr = (const v2u*)(XB + (size_t)m * D) + F.lane;
#pragma unroll
        for (int j = 0; j < 8; ++j) v[j] = xr[64 * j];
        q0 = ssq[m]; q1 = ssq[m + 1]; }
#pragma unroll 1
    for (; m < M; m += 2 * NGW) { const int mn = m + 2 * NGW; v2u w[8]; float n0 = 0.f, n1 = 0.f;
        if (mn < M) { const v2u* xn = (const v2u*)(XB + (size_t)mn * D) + F.lane;
#pragma unroll
            for (int j = 0; j < 8; ++j) w[j] = xn[64 * j];
            n0 = ssq[mn]; n1 = ssq[mn + 1]; }
        const float rs0 = frsq(q0 * (1.0f / D) + EPS), rs1 = frsq(q1 * (1.0f / D) + EPS);
        f32x4* xo = (f32x4*)(a.out + (size_t)m * D) + F.lane;
#pragma unroll
        for (int j = 0; j < 8; ++j) { const f32x4 x = (f32x4){bflo(v[j].x), bfhi(v[j].x), bflo(v[j].y), bfhi(v[j].y)}; __builtin_nontemporal_store(x * (j < 4 ? rs0 : rs1) * gv[j & 3], xo + 64 * j); }
#pragma unroll
        for (int j = 0; j < 8; ++j) v[j] = w[j];
        q0 = n0; q1 = n1; }
}

typedef __attribute__((address_space(1))) unsigned gu32;
#define RLX_AGENT __ATOMIC_RELAXED, __HIP_MEMORY_SCOPE_AGENT
#define XB_TMO      128
#define XB_XCNT(j)  (256  + 64 * (j))
#define XB_XSUB(j)  (1280 + 64 * (j))
#define XB_XGEN(j)  (2304 + 64 * (j))
#define XB_TOP      3328
#define XB_TOPGEN   3392
#define XCD_BAR_WORDS 3456
#define XB_SPIN_CAP (1u << 18)

__device__ __forceinline__ unsigned xb_ld(unsigned* p)              { return __hip_atomic_load(p, __ATOMIC_RELAXED, __HIP_MEMORY_SCOPE_AGENT); }
__device__ __forceinline__ unsigned xb_add(unsigned* p, unsigned v) { return __hip_atomic_fetch_add(p, v, __ATOMIC_RELAXED, __HIP_MEMORY_SCOPE_AGENT); }
__device__ __forceinline__ unsigned xb_xcc_id() { return (unsigned)__builtin_amdgcn_s_getreg((3 << 11) | 20) & 0xFu; }
#define XB_SPIN(cond, bar) do { unsigned _sp = 0; while (cond) { __builtin_amdgcn_s_sleep(1); \
    if ((++_sp & 255u) == 0u) { if (xb_ld(&(bar)[XB_TMO])) break; if (_sp > XB_SPIN_CAP) { atomicAdd(&(bar)[XB_TMO], 1u); break; } } } } while (0)

struct XcdBarrier {
    unsigned* bar; unsigned x;
    volatile LAS unsigned* st;
};

__device__ __forceinline__ XcdBarrier xcd_barrier_post(unsigned* bar, volatile LAS unsigned* st) {
    XcdBarrier b; b.bar = bar; b.x = xb_xcc_id(); b.st = st;
    if (mk_tid() == 0) (void)xb_add(&bar[XB_XCNT(b.x)], 1u);
    return b;
}
__device__ __forceinline__ void xcd_barrier_complete(unsigned* bar, unsigned x, unsigned& nloc, unsigned& nx) {
    const unsigned G = gridDim.x * gridDim.y * gridDim.z;
    unsigned sum, cnt, mine, sp = 0u;
    for (;;) {
        sum = 0u; cnt = 0u; mine = 0u;
#pragma unroll
        for (unsigned j = 0; j < 16; ++j) { const unsigned c = xb_ld(&bar[XB_XCNT(j)]); sum += c; cnt += (c > 0u) ? 1u : 0u; mine = (j == x) ? c : mine; }
        if (sum == G) break;
        __builtin_amdgcn_s_sleep(1);
        if ((++sp & 255u) == 0u) { if (xb_ld(&bar[XB_TMO])) break; if (sp > XB_SPIN_CAP) { atomicAdd(&bar[XB_TMO], 1u); break; } }
    }
    nloc = mine > 0u ? mine : 1u; nx = cnt > 0u ? cnt : 1u;
}

__device__ __forceinline__ void xcd_barrier(const XcdBarrier& b) {
    asm volatile("s_waitcnt vmcnt(0)" ::: "memory");
    __syncthreads();
    if (mk_tid() == 0) {
        unsigned* bar = b.bar;
        __builtin_amdgcn_s_waitcnt(0);
        unsigned nloc = b.st[0], nx = b.st[1];
        if (nloc == 0u) { xcd_barrier_complete(bar, b.x, nloc, nx); b.st[0] = nloc; b.st[1] = nx; }
        const unsigned old = xb_add(&bar[XB_XSUB(b.x)], 1u);
        const unsigned gen = old / nloc;
        if (old + 1u == (gen + 1u) * nloc) {
            __builtin_amdgcn_fence(__ATOMIC_RELEASE, "agent");
            asm volatile("s_waitcnt vmcnt(0)" ::: "memory");
            const unsigned og = xb_add(&bar[XB_TOP], 1u);
            const unsigned tg = og / nx;
            if (og + 1u == (tg + 1u) * nx) xb_add(&bar[XB_TOPGEN], 1u);
            else XB_SPIN(xb_ld(&bar[XB_TOPGEN]) == tg, bar);
            __builtin_amdgcn_fence(__ATOMIC_ACQUIRE, "agent");
            xb_add(&bar[XB_XGEN(b.x)], 1u);
            asm volatile("s_waitcnt vmcnt(0)" ::: "memory");
        } else {
            XB_SPIN(xb_ld(&bar[XB_XGEN(b.x)]) == gen, bar);
            __builtin_amdgcn_fence(__ATOMIC_ACQUIRE, "agent");
            asm volatile("s_waitcnt vmcnt(0)" ::: "memory");
        }
    }
    __syncthreads();
}

constexpr int MISC_OFF = RING_BYTES + 320;
constexpr size_t WS_BAR = 65536;
#ifndef MK_MULTI
#define MK_MULTI 0
#endif
constexpr int N_PHASES = 15;
__device__ __forceinline__ Args load_args() {
    const __attribute__((address_space(4))) Args* p = (const __attribute__((address_space(4))) Args*)__builtin_amdgcn_kernarg_segment_ptr(); asm volatile("" : "+s"(p)); const Args* g = (const Args*)p; return *g; }
__global__ void __launch_bounds__(NWAVES * 64, 2) mk_fwd(Args args_) {
    extern __shared__ __attribute__((aligned(16))) unsigned char lds[];
    Frame F; F.lds = (LAS unsigned char*)lds;
    { const int t0_ = threadIdx.x; const unsigned hw = __builtin_amdgcn_s_getreg(4 | ((6 - 1) << 11)) & 63u; if ((t0_ & 63) == 0) ((LAS int*)(F.lds + RING_BYTES))[hw] = t0_ >> 6; }
    __syncthreads();
    F.tid = mk_tid(); F.lane = F.tid & 63; F.wave = __builtin_amdgcn_readfirstlane(F.tid >> 6);
    F.G = gridDim.x; { const int bx = blockIdx.x; F.vcu = (F.G % 8 == 0) ? (bx % 8) * (F.G / 8) + bx / 8 : bx; }
    const int lo = MK_MULTI ? args_.ph_lo : 0, hi = MK_MULTI ? args_.ph_hi : N_PHASES;
    if (F.tid < 32) ((LAS unsigned*)(F.lds + MISC_OFF))[F.tid] = 0u;
    __syncthreads();
    XcdBarrier bar; bar.bar = nullptr; bar.x = 0; bar.st = nullptr;
    if (!MK_MULTI) bar = xcd_barrier_post((unsigned*)(args_.ws + WS_BAR), (volatile LAS unsigned*)(F.lds + MISC_OFF) + 8);
    if (args_.ph_hi == 0x7fffffff) cg::this_grid().sync();
#ifndef PH_MASK
#define PH_MASK 0x7fff
#endif
#define IN(k) (((PH_MASK >> (k)) & 1) && lo <= (k) && (k) < hi)
#define SEAM(k) do { if (IN(k) && IN((k) + 1)) { xcd_barrier(bar); } { int t_ = mk_tid(); asm volatile("" : "+v"(t_)); F.tid = t_; F.lane = t_ & 63; F.wave = __builtin_amdgcn_readfirstlane(t_ >> 6); } } while (0)
#define PH_ARGS() const Args args = load_args(); unsigned char* ws = args.ws; bf16* XB = (bf16*)(ws + WS_XB); float* ssq = (float*)(ws + WS_SSQ); (void)XB; (void)ssq
    if (IN(0)) { PH_ARGS(); if (MK_MULTI && blockIdx.x == 0) { unsigned* bw = (unsigned*)(ws + WS_BAR); for (int i = F.tid; i < 4096 + 64; i += NWAVES * 64) bw[i] = 0u; } p0_prologue(F, args); } SEAM(0);
    if (IN(1)) { PH_ARGS(); thin_gemm16<0>(F, XB, (const bf16*)(ws + WS_WG0), (const float*)(ws + WS_RSTD0), nullptr, ws + WS_GLB); __syncthreads();
        pg8::Gemm g{XB, (const bf16*)(ws + WS_WIN0), M, N0P, D}; pg8::StaticOrder S; S.init(M, N0P, F.G, (int)blockIdx.x);
        pg8::EpiScaleBf16<0, 0> E{(bf16*)(ws + WS_PROJ0), N0P, (const float*)(ws + WS_RSTD0)};
        pg8::gemm_phase<pg8::EpiScaleBf16<0, 0>, pg8::StaticOrder, true, true>(F.lds, g, S, E); } SEAM(1);
    if (IN(2)) { PH_ARGS(); gla_pass_a(F, args); } SEAM(2);
    if (IN(3)) { PH_ARGS(); gla_scan(F, args); } SEAM(3);
    if (IN(4)) { PH_ARGS(); gla_pass_c(F, args); } SEAM(4);
    if (IN(5)) { PH_ARGS(); pg8::Gemm g{(const bf16*)(ws + WS_Y0), (const bf16*)(ws + WS_WOUT0), M, D, D}; pg8::StaticOrder S; S.init(M, D, F.G, (int)blockIdx.x);
        typedef pg8::EpiRes<true, false, true> ER; ER E{nullptr, XB, nullptr, XB, ssq};
        pg8::gemm_phase<ER, pg8::StaticOrder, true, true>(F.lds, g, S, E); } SEAM(5);
    if (IN(6)) { PH_ARGS(); pg8::Gemm g{XB, (const bf16*)(ws + WS_W1A), M, FF, D}; pg8::StaticOrder S; S.init(M, FF, F.G, (int)blockIdx.x);
        pg8::EpiScaleBf16<1, 1> E{(bf16*)(ws + WS_U), FF, ssq};
        pg8::gemm_phase<pg8::EpiScaleBf16<1, 1>, pg8::StaticOrder, true, true>(F.lds, g, S, E); } SEAM(6);
    if (IN(7)) { PH_ARGS(); pg8::Gemm g{(const bf16*)(ws + WS_U), (const bf16*)(ws + WS_W2A), M, D, FF}; pg8::StaticOrder S; S.init(M, D, F.G, (int)blockIdx.x);
        typedef pg8::EpiRes<true, false, true> ER; ER E{nullptr, XB, nullptr, XB, ssq + M};
        pg8::gemm_phase<ER, pg8::StaticOrder, true, true>(F.lds, g, S, E); } SEAM(7);
    if (IN(8)) { PH_ARGS(); thin_gemm16<1>(F, XB, (const bf16*)(ws + WS_WF1), ssq + M, args.in[12], ws + WS_LF); __syncthreads();
        pg8::Gemm g{XB, (const bf16*)(ws + WS_WIN1), M, N1P, D}; pg8::StaticOrder S; S.init(M, N1P, F.G, (int)blockIdx.x);
        pg8::EpiFox E{(bf16*)(ws + WS_Q), (bf16*)(ws + WS_K), (bf16*)(ws + WS_V), (bf16*)(ws + WS_G), (float*)(ws + WS_LF), ssq + M, args.in[13], args.in[14], args.in[12], attn_body::C2, (unsigned*)(ws + WS_BAR) + 4096 + 128};
        pg8::gemm_phase<pg8::EpiFox, pg8::StaticOrder, true, true>(F.lds, g, S, E); } SEAM(8);
    if (IN(9)) { PH_ARGS(); fox_cumsum(F, args); } SEAM(9);
    if (IN(10)) { PH_ARGS(); const attn_body::AttnTensors AT{(const attn_body::bf16*)(ws + WS_Q), (const attn_body::bf16*)(ws + WS_K), (const attn_body::bf16*)(ws + WS_V), (const attn_body::bf16*)(ws + WS_G),
                                               (const float*)(ws + WS_CB), args.in[13], args.in[14], (attn_body::bf16*)(ws + WS_O), (unsigned*)(ws + WS_BAR) + 4096, (const unsigned*)(ws + WS_BAR) + 4096 + 128};
        const attn_body::StaticOrder S((int)F.G, (int)blockIdx.x);
        attn_body::attn_phase<attn_body::StaticOrder>((char*)lds, AT, S); } SEAM(10);
    if (IN(11)) { PH_ARGS(); pg8::Gemm g{(const bf16*)(ws + WS_O), (const bf16*)(ws + WS_WOUT1), M, D, D}; pg8::StaticOrder S; S.init(M, D, F.G, (int)blockIdx.x);
        typedef pg8::EpiRes<true, false, true> ER; ER E{nullptr, XB, nullptr, XB, ssq + 2 * M};
        pg8::gemm_phase<ER, pg8::StaticOrder, true, true>(F.lds, g, S, E); } SEAM(11);
    if (IN(12)) { PH_ARGS(); pg8::Gemm g{XB, (const bf16*)(ws + WS_W1B), M, FF, D}; pg8::StaticOrder S; S.init(M, FF, F.G, (int)blockIdx.x);
        pg8::EpiScaleBf16<1, 1> E{(bf16*)(ws + WS_U), FF, ssq + 2 * M};
        pg8::gemm_phase<pg8::EpiScaleBf16<1, 1>, pg8::StaticOrder, true, true>(F.lds, g, S, E); } SEAM(12);
    if (IN(13)) { PH_ARGS(); pg8::Gemm g{(const bf16*)(ws + WS_U), (const bf16*)(ws + WS_W2B), M, D, FF}; pg8::StaticOrder S; S.init(M, D, F.G, (int)blockIdx.x);
        typedef pg8::EpiRes<true, false, true> ER; ER E{nullptr, XB, nullptr, XB, ssq + 3 * M};
        pg8::gemm_phase<ER, pg8::StaticOrder, true, true>(F.lds, g, S, E); } SEAM(13);
    if (IN(14)) { PH_ARGS(); final_norm(F, args); }
#undef IN
#undef SEAM
}

extern "C" void kernel_launch(void* const* d_in, const int* in_sizes, int n_in, void* d_out, int out_size, void* d_ws, size_t ws_size, hipStream_t stream) {
    static int grid = 0;
    if (grid == 0) {
        if (n_in != 20 || in_sizes[0] != M * D || out_size != M * D || ws_size < WS_END) { fprintf(stderr, "kernel_launch: unexpected shapes (n_in %d, in0 %d, out %d, ws %zu); nothing launched\n", n_in, n_in > 0 ? in_sizes[0] : -1, out_size, ws_size); grid = -1; return; }
        int dev = 0, cus = 0, per_cu = 0;
        if (hipGetDevice(&dev) != hipSuccess || hipDeviceGetAttribute(&cus, hipDeviceAttributeMultiprocessorCount, dev) != hipSuccess) { grid = -1; return; }
        if (hipFuncSetAttribute((const void*)mk_fwd, hipFuncAttributeMaxDynamicSharedMemorySize, LDS_BYTES) != hipSuccess) { fprintf(stderr, "kernel_launch: hipFuncSetAttribute failed\n"); grid = -1; return; }
        if (hipOccupancyMaxActiveBlocksPerMultiprocessor(&per_cu, (const void*)mk_fwd, NWAVES * 64, LDS_BYTES) != hipSuccess || per_cu < 1) { fprintf(stderr, "kernel_launch: occupancy query says %d blocks per CU\n", per_cu); per_cu = 1; }
        (void)hipGetLastError();
        grid = cus;
        if (grid != 256) fprintf(stderr, "kernel_launch: note: %d CUs (the attention order is balanced for 256)\n", grid);
    }
    if (grid < 0) return;
    Args a{};
    for (int i = 0; i < 20; ++i) a.in[i] = (const float*)d_in[i];
    a.out = (float*)d_out; a.ws = (unsigned char*)d_ws;
#if MK_MULTI
    for (int p = 0; p < N_PHASES; ++p) { a.ph_lo = p; a.ph_hi = p + 1; hipLaunchKernelGGL(mk_fwd, dim3(grid), dim3(NWAVES * 64), LDS_BYTES, stream, a); }
#else
    a.ph_lo = 0; a.ph_hi = N_PHASES;
    if (hipMemsetAsync((char*)d_ws + WS_BAR, 0, (4096 + 64) * 4, stream) != hipSuccess) { fprintf(stderr, "kernel_launch: hipMemsetAsync of the barrier / queue words failed; nothing launched\n"); return; }
    void* kargs[] = {&a};
    const hipError_t e = hipLaunchCooperativeKernel((const void*)mk_fwd, dim3(grid), dim3(NWAVES * 64), kargs, LDS_BYTES, stream);
    if (e != hipSuccess) fprintf(stderr, "kernel_launch: cooperative launch failed: %s (grid %d)\n", hipGetErrorString(e), grid);
#endif
}
```
